# Optimizing an MI355X kernel written in HIP

```python
import math
import jax, jax.numpy as jnp
from jax import lax
import numpy as np

D_MODEL = 1024
BATCH = 8
SEQ = 4096
DEPTH = 2

ATTN_WIDTH = D_MODEL // 2
ATTN_HEAD_DIM = 64
ATTN_QK_DIM = ATTN_HEAD_DIM // 2
ATTN_HEADS = ATTN_WIDTH // ATTN_HEAD_DIM
POOL_WIDTH = D_MODEL // 4
POOL_WINDOWS = (2, 4, 8, 16)
POOL_GROUPS = len(POOL_WINDOWS)
POOL_GROUP_DIM = POOL_WIDTH // POOL_GROUPS
CONV_WIDTH = D_MODEL // 4
CONV_GROUPS = 4
CONV_K = 3
MIX_WIDTH = ATTN_WIDTH + POOL_WIDTH + CONV_WIDTH
IN_WIDTH = 3 * ATTN_WIDTH + POOL_WIDTH + 3 * CONV_WIDTH
D_FF = ((8 * D_MODEL // 3 + 255) // 256) * 256
Q_BLOCK = 128
EPS = 1e-6

kernel_name = "hymba_style_diffattn_pool_shortconv_encoder"


def rmsnorm(x, g):
    xf = x.astype(jnp.float32)
    y = xf * lax.rsqrt(jnp.mean(xf * xf, axis=-1, keepdims=True) + EPS)
    return (y * g.astype(jnp.float32)).astype(x.dtype)


def alibi_slopes(n_heads):
    return jnp.asarray(np.array([2.0 ** (-8.0 * (h + 1) / n_heads) for h in range(n_heads)], dtype=np.float32))


def diff_attention(q, k, v, lam, slopes):
    b_, s_ = q.shape[0], q.shape[1]
    nblk = s_ // Q_BLOCK
    scale = ATTN_QK_DIM ** -0.5
    qb = q.reshape(b_, nblk, Q_BLOCK, ATTN_HEADS, 2, ATTN_QK_DIM).transpose(1, 0, 2, 3, 4, 5)
    kpos = jnp.arange(s_)

    def one_block(args):
        qi, blk = args
        qpos = blk * Q_BLOCK + jnp.arange(Q_BLOCK)
        dist = jnp.abs(qpos[:, None] - kpos[None, :]).astype(jnp.float32)
        bias = -slopes[:, None, None] * dist[None]
        s = jnp.einsum('bqhpd,bkhpd->bphqk', qi, k).astype(jnp.float32) * scale + bias
        p = jax.nn.softmax(s, axis=-1)
        w = p[:, 0] - lam * p[:, 1]
        return jnp.einsum('bhqk,bkhd->bqhd', w.astype(v.dtype), v)

    out = lax.map(one_block, (qb, jnp.arange(nblk)))
    return out.transpose(1, 0, 2, 3, 4).reshape(b_, s_, ATTN_HEADS, ATTN_HEAD_DIM)


def multiscale_pool(u, w_pool, pool_scale):
    b_, s_, _ = u.shape
    uf = u.astype(jnp.float32)
    csum = jnp.concatenate([jnp.zeros((b_, 1, POOL_WIDTH), jnp.float32), jnp.cumsum(uf, axis=1)], axis=1)
    t = jnp.arange(s_)
    pooled = []
    for g, w in enumerate(POOL_WINDOWS):
        cg = csum[..., g * POOL_GROUP_DIM:(g + 1) * POOL_GROUP_DIM]
        lo = jnp.clip(t - w // 2, 0, s_)
        hi = jnp.clip(t + w - w // 2, 0, s_)
        total = jnp.take(cg, hi, axis=1) - jnp.take(cg, lo, axis=1)
        cnt = (hi - lo).astype(jnp.float32)
        pooled.append(total / cnt[None, :, None])
    pooled = jnp.stack(pooled, axis=2)
    diff = pooled - uf.reshape(b_, s_, POOL_GROUPS, POOL_GROUP_DIM)
    mixed = jnp.einsum('bsgc,gcd->bsgd', diff, w_pool.astype(jnp.float32))
    return (mixed.reshape(b_, s_, POOL_WIDTH) * pool_scale.astype(jnp.float32)).astype(u.dtype)


def short_gated_conv(b_gate, c_gate, xh, conv_w):
    u = c_gate * xh
    up = jnp.pad(u, ((0, 0), (1, 1), (0, 0)))
    y = conv_w[0] * up[:, :-2] + conv_w[1] * up[:, 1:-1] + conv_w[2] * up[:, 2:]
    return b_gate * y


def modulate(h, shift, scale):
    return h * (1.0 + scale[:, None, :]) + shift[:, None, :]


def setup_inputs(seed: int = 0) -> dict:
    key = jax.random.key(seed)
    ks = jax.random.split(key, 20)
    f32 = jnp.float32
    n = lambda k, shape, s: jax.random.normal(k, shape, f32) * s
    return {
        "x": n(ks[0], (BATCH, SEQ, D_MODEL), 1.0),
        "c": n(ks[1], (BATCH, D_MODEL), 1.0),
        "w_ada": n(ks[2], (DEPTH, D_MODEL, 6 * D_MODEL), D_MODEL ** -0.5),
        "b_ada": n(ks[3], (DEPTH, 6 * D_MODEL), 0.02),
        "g_mix": 1.0 + n(ks[4], (DEPTH, D_MODEL), 0.1),
        "w_in": n(ks[5], (DEPTH, D_MODEL, IN_WIDTH), D_MODEL ** -0.5),
        "lambda_q1": n(ks[6], (DEPTH, ATTN_QK_DIM), 0.1),
        "lambda_k1": n(ks[7], (DEPTH, ATTN_QK_DIM), 0.1),
        "lambda_q2": n(ks[8], (DEPTH, ATTN_QK_DIM), 0.1),
        "lambda_k2": n(ks[9], (DEPTH, ATTN_QK_DIM), 0.1),
        "g_subln": 1.0 + n(ks[10], (DEPTH, ATTN_WIDTH), 0.1),
        "w_pool": n(ks[11], (DEPTH, POOL_GROUPS, POOL_GROUP_DIM, POOL_GROUP_DIM), POOL_GROUP_DIM ** -0.5),
        "pool_scale": 1.0 + n(ks[12], (DEPTH, POOL_WIDTH), 0.1),
        "conv_w": n(ks[13], (DEPTH, CONV_K, CONV_WIDTH), 0.5),
        "w_out": n(ks[14], (DEPTH, MIX_WIDTH, D_MODEL), MIX_WIDTH ** -0.5),
        "g_ffn": 1.0 + n(ks[15], (DEPTH, D_MODEL), 0.1),
        "w_gate_up": n(ks[16], (DEPTH, D_MODEL, 2 * D_FF), D_MODEL ** -0.5),
        "w_down": n(ks[17], (DEPTH, D_FF, D_MODEL), D_FF ** -0.5),
        "g_final": 1.0 + n(ks[18], (D_MODEL,), 0.1),
    }


def reference(x, c, w_ada, b_ada, g_mix, w_in, lambda_q1, lambda_k1, lambda_q2, lambda_k2,
              g_subln, w_pool, pool_scale, conv_w, w_out, g_ffn, w_gate_up, w_down, g_final):
    b_, s_, _ = x.shape
    slopes = alibi_slopes(ATTN_HEADS)
    c_act = jax.nn.silu(c)
    o_q, o_k, o_v = ATTN_WIDTH, 2 * ATTN_WIDTH, 3 * ATTN_WIDTH
    o_p = o_v + POOL_WIDTH
    o_b, o_c = o_p + CONV_WIDTH, o_p + 2 * CONV_WIDTH
    for l in range(DEPTH):
        mod = c_act @ w_ada[l] + b_ada[l]
        sh1, sc1, gt1, sh2, sc2, gt2 = jnp.split(mod, 6, axis=-1)

        h = modulate(rmsnorm(x, g_mix[l]), sh1, sc1)
        proj = h @ w_in[l]
        q = proj[..., :o_q].reshape(b_, s_, ATTN_HEADS, 2, ATTN_QK_DIM)
        k = proj[..., o_q:o_k].reshape(b_, s_, ATTN_HEADS, 2, ATTN_QK_DIM)
        v = proj[..., o_k:o_v].reshape(b_, s_, ATTN_HEADS, ATTN_HEAD_DIM)
        u_pool = proj[..., o_v:o_p]
        b_gate, c_gate, x_conv = proj[..., o_p:o_b], proj[..., o_b:o_c], proj[..., o_c:]

        lambda_init = 0.8 - 0.6 * math.exp(-0.3 * l)
        lam = (jnp.exp(jnp.sum(lambda_q1[l].astype(jnp.float32) * lambda_k1[l].astype(jnp.float32)))
               - jnp.exp(jnp.sum(lambda_q2[l].astype(jnp.float32) * lambda_k2[l].astype(jnp.float32)))
               + lambda_init)
        attn = diff_attention(q, k, v, lam, slopes)
        attn = rmsnorm(attn, g_subln[l].reshape(ATTN_HEADS, ATTN_HEAD_DIM)) * (1.0 - lambda_init)
        y_a = attn.reshape(b_, s_, ATTN_WIDTH)
        y_b = multiscale_pool(u_pool, w_pool[l], pool_scale[l])
        y_c = short_gated_conv(b_gate, c_gate, x_conv, conv_w[l])

        mixed = jnp.concatenate([y_a, y_b, y_c], axis=-1) @ w_out[l]
        x = x + gt1[:, None, :] * mixed

        h = modulate(rmsnorm(x, g_ffn[l]), sh2, sc2)
        gate, up = jnp.split(h @ w_gate_up[l], 2, axis=-1)
        x = x + gt2[:, None, :] * ((jax.nn.silu(gate) * up) @ w_down[l])

    return rmsnorm(x, g_final)
```

```cpp
#include <hip/hip_runtime.h>
#include <hip/hip_cooperative_groups.h>
#include <cstdio>
#include <cstdint>
namespace cg = cooperative_groups;

typedef unsigned short bf16_t;
constexpr int BATCH = 8, SEQ = 4096, D = 1024, M = BATCH * SEQ, DEPTH = 2;
constexpr int INW = 2560, DFF = 2816, NGU = 2 * DFF;
constexpr int O_Q = 0, O_K = 512, O_V = 1024, O_P = 1536, O_B = 1792, O_C = 2048, O_X = 2304;
constexpr float EPS = 1e-6f;
constexpr float LOG2E = 1.4426950408889634f;
constexpr float C2 = 0.17677669529663687f * 1.4426950408889634f;

__device__ __forceinline__ float bf2f(bf16_t v) { return __uint_as_float(((unsigned)v) << 16); }
__device__ __forceinline__ bf16_t f2bf(float f) { unsigned u = __float_as_uint(f); return (bf16_t)((u + 0x7fffu + ((u >> 16) & 1u)) >> 16); }
__device__ __forceinline__ unsigned pk2(float lo, float hi) { return (unsigned)f2bf(lo) | ((unsigned)f2bf(hi) << 16); }

constexpr size_t MiB = 1u << 20;
constexpr size_t WS_CTL = 0, CTL_ZERO_BYTES = 128 * 1024;
constexpr size_t WS_KN2 = 64 * 1024;
constexpr size_t WS_MOD = 1 * MiB;
constexpr size_t WS_WIN = 2 * MiB;
constexpr size_t WS_WOUT = 12 * MiB;
constexpr size_t WS_WGU = 16 * MiB;
constexpr size_t WS_WDN = 38 * MiB;
constexpr size_t WS_WPT = 49 * MiB;
constexpr size_t WS_H = 50 * MiB;
constexpr size_t WS_MIX = 114 * MiB;
constexpr size_t BPAD = (size_t)SEQ * (DFF - INW);
constexpr size_t WS_PROJ = 178 * MiB;
constexpr size_t WS_ACT = 178 * MiB;
constexpr size_t WS_XB = 354 * MiB;
constexpr size_t WS_PART = 418 * MiB;
constexpr size_t WS_END = 420 * MiB;

__device__ __forceinline__ int launder_v(int v) { asm volatile("" : "+v"(v)); return v; }
__device__ __forceinline__ int launder_s(int v) { asm volatile("" : "+s"(v)); return v; }
#define GAS __attribute__((address_space(1)))
#define LAS __attribute__((address_space(3)))
typedef GAS unsigned gu32;
#define RLX_AGENT __ATOMIC_RELAXED, __HIP_MEMORY_SCOPE_AGENT
#define LDS_WAIT() asm volatile("s_waitcnt lgkmcnt(0)" ::: "memory")
#define VM_WAIT() asm volatile("s_waitcnt vmcnt(0)" ::: "memory")

namespace pg8 {
#define PG8_LAS __attribute__((address_space(3)))
typedef unsigned short bf16_t;
typedef short bf16x8 __attribute__((ext_vector_type(8)));
typedef float f32x4 __attribute__((ext_vector_type(4)));
typedef unsigned u32x4 __attribute__((ext_vector_type(4)));
constexpr int BM = 256, BK = 64, HALF = 128, HTB = HALF * BK * 2  , STAGE_BYTES = 8 * HTB, NXCD = 8, WGM = 4;

__host__ __device__ __forceinline__ int lds_byte(int r, int c) { const int st = (r >> 4) * 2 + (c >> 5), rr = r & 15, cc = c & 31, ob = rr * 64 + cc * 2; return st * 1024 + (ob ^ (((ob >> 9) & 1) << 5)); }
__host__ __device__ __forceinline__ void stage_rc(int b, int& R, int& C) { const int st = b / 1024, sb = b % 1024, swz = sb ^ (((sb >> 9) & 1) << 5); R = (st >> 1) * 16 + swz / 64; C = (st & 1) * 32 + (swz % 64) / 2; }
__host__ __device__ __forceinline__ int perm32(int rho) { const int n = rho >> 4, i = rho & 15; return 8 * (i >> 2) + 4 * n + (i & 3); }

struct Unit { int pm, pn; };
struct Gemm { const bf16_t* A; const bf16_t* Bt; int M, N, K; };

struct StaticOrder {
    int nM, nN, nwg, G, c;
    __host__ __device__ void init(int M, int N, int G_, int c_) { nM = M / BM; nN = N / BM; nwg = nM * nN; G = G_; c = c_; }
    __host__ __device__ bool next(int i, Unit& u) const {
        const long L = (long)i * G + c; if (L >= nwg) return false;
        int wgid = (int)L; { const int q = nwg / NXCD, r = nwg % NXCD, xcd = wgid % NXCD, off = wgid / NXCD; wgid = (xcd < r ? xcd * (q + 1) : r * (q + 1) + (xcd - r) * q) + off; }
        const int nig = WGM * nN, gid = wgid / nig, fm = gid * WGM, gsz = (nM - fm) < WGM ? (nM - fm) : WGM;
        u.pm = fm + ((wgid % nig) % gsz); u.pn = (wgid % nig) / gsz; return true;
    }
    __device__ __forceinline__ void a_ready(const Unit&) const {}
    __device__ __forceinline__ void done(const Unit&) const {}
};

__device__ __forceinline__ unsigned cvt_pk_bf16(float lo, float hi) { unsigned r; asm volatile("v_cvt_pk_bf16_f32 %0, %1, %2" : "=v"(r) : "v"(lo), "v"(hi)); return r; }
typedef float f32x2 __attribute__((ext_vector_type(2)));
struct EpiProj {
    static constexpr bool PERM = true, AFTER_DRAIN = false;
    bf16_t* O; int ldc; float qscale; unsigned* kn2; size_t bpad;
    __device__ __forceinline__ void operator()(const f32x4 (&acc)[2][2][4][2], const Unit& u, int wr, int wc, int fr, int fq) const {
        const int row0 = u.pm * BM + wr * 64 + fr, col0 = u.pn * BM + wc * 32 + 8 * fq;
        const float sc = u.pn < 2 ? qscale : 1.f;
#pragma unroll
        for (int ai = 0; ai < 2; ++ai)
#pragma unroll
            for (int m = 0; m < 4; ++m) { bf16_t* rowp = O + (size_t)(u.pm >> 4) * bpad + (size_t)(row0 + ai * HALF + m * 16) * ldc + col0;
#pragma unroll
                for (int bj = 0; bj < 2; ++bj) { const f32x4 v0 = acc[ai][bj][m][0] * sc, v1 = acc[ai][bj][m][1] * sc;
                    u32x4 w; w.x = cvt_pk_bf16(v0[0], v0[1]); w.y = cvt_pk_bf16(v0[2], v0[3]); w.z = cvt_pk_bf16(v1[0], v1[1]); w.w = cvt_pk_bf16(v1[2], v1[3]);
                    *(u32x4*)(rowp + bj * HALF) = w; } }
        if (u.pn == 2 || u.pn == 3) {
#pragma unroll
            for (int ai = 0; ai < 2; ++ai)
#pragma unroll
                for (int bj = 0; bj < 2; ++bj) { float mx = 0.f;
#pragma unroll
                    for (int m = 0; m < 4; ++m) { const f32x4 a = acc[ai][bj][m][0], b = acc[ai][bj][m][1];
                        float ss = (a[0] * a[0] + a[1] * a[1]) + (a[2] * a[2] + a[3] * a[3]) + (b[0] * b[0] + b[1] * b[1]) + (b[2] * b[2] + b[3] * b[3]);
                        ss += __shfl_xor(ss, 16); ss += __shfl_xor(ss, 32); mx = fmaxf(mx, ss); }
                    mx = fmaxf(mx, __shfl_xor(mx, 1)); mx = fmaxf(mx, __shfl_xor(mx, 2)); mx = fmaxf(mx, __shfl_xor(mx, 4)); mx = fmaxf(mx, __shfl_xor(mx, 8));
                    if (fr == 0 && fq == 0) { const int b = u.pm >> 4, tile = (u.pm * 4 + ai * 2 + wr) & 63, head = (u.pn - 2) * 4 + bj * 2 + (wc >> 1), half = wc & 1;
                        atomicMax(kn2 + ((b * 8 + head) * 2 + half) * 64 + tile, __float_as_uint(mx)); } }
        }
    }
};
__device__ __forceinline__ float silu_mul(float g, float u) { return g * u * __builtin_amdgcn_rcpf(1.f + __builtin_amdgcn_exp2f(-1.4426950408889634f * g)); }
struct EpiSwiglu {
    static constexpr bool PERM = true, AFTER_DRAIN = false;
    bf16_t* O; int ldc;
    __device__ __forceinline__ void operator()(const f32x4 (&acc)[2][2][4][2], const Unit& u, int wr, int wc, int fr, int fq) const {
        const int row0 = u.pm * BM + wr * 64 + fr, col0 = u.pn * HALF + wc * 32 + 8 * fq;
#pragma unroll
        for (int ai = 0; ai < 2; ++ai)
#pragma unroll
            for (int m = 0; m < 4; ++m) { bf16_t* rowp = O + (size_t)(row0 + ai * HALF + m * 16) * ldc + col0;
                const f32x4 g0 = acc[ai][0][m][0], g1 = acc[ai][0][m][1], u0 = acc[ai][1][m][0], u1 = acc[ai][1][m][1];
                u32x4 w; w.x = cvt_pk_bf16(silu_mul(g0[0], u0[0]), silu_mul(g0[1], u0[1])); w.y = cvt_pk_bf16(silu_mul(g0[2], u0[2]), silu_mul(g0[3], u0[3]));
                w.z = cvt_pk_bf16(silu_mul(g1[0], u1[0]), silu_mul(g1[1], u1[1])); w.w = cvt_pk_bf16(silu_mul(g1[2], u1[2]), silu_mul(g1[3], u1[3]));
                *(u32x4*)rowp = w; }
    }
};
template <bool BASE_F32>
struct EpiResid {
    static constexpr bool PERM = true, AFTER_DRAIN = false;
    const void* base; bf16_t* out; int ldc; const float* gt; int rows_per_batch;
    __device__ __forceinline__ void operator()(const f32x4 (&acc)[2][2][4][2], const Unit& u, int wr, int wc, int fr, int fq) const {
        const int col0 = u.pn * BM + wc * 32 + 8 * fq; const int b = (u.pm * BM) / rows_per_batch;
        f32x4 gv[2][2];
#pragma unroll
        for (int bj = 0; bj < 2; ++bj)
#pragma unroll
            for (int n = 0; n < 2; ++n) gv[bj][n] = *(const f32x4*)(gt + (size_t)b * 6144 + col0 + bj * HALF + 4 * n);
#pragma unroll
        for (int ai = 0; ai < 2; ++ai) {
            u32x4 wb[4][2]; f32x4 wf[BASE_F32 ? 4 : 1][2][2];
#pragma unroll
            for (int m = 0; m < 4; ++m) { const size_t off = (size_t)(u.pm * BM + ai * HALF + wr * 64 + m * 16 + fr) * ldc + col0;
#pragma unroll
                for (int bj = 0; bj < 2; ++bj) {
                    if (BASE_F32) { wf[m][bj][0] = *(const f32x4*)((const float*)base + off + bj * HALF); wf[m][bj][1] = *(const f32x4*)((const float*)base + off + bj * HALF + 4); }
                    else wb[m][bj] = *(const u32x4*)((const bf16_t*)base + off + bj * HALF); } }
#pragma unroll
            for (int m = 0; m < 4; ++m) { const size_t off = (size_t)(u.pm * BM + ai * HALF + wr * 64 + m * 16 + fr) * ldc + col0;
#pragma unroll
                for (int bj = 0; bj < 2; ++bj) { f32x4 b0, b1;
                    if (BASE_F32) { b0 = wf[m][bj][0]; b1 = wf[m][bj][1]; }
                    else { const u32x4 w = wb[m][bj];
                        b0 = (f32x4){__uint_as_float(w.x << 16), __uint_as_float(w.x & 0xffff0000u), __uint_as_float(w.y << 16), __uint_as_float(w.y & 0xffff0000u)};
                        b1 = (f32x4){__uint_as_float(w.z << 16), __uint_as_float(w.z & 0xffff0000u), __uint_as_float(w.w << 16), __uint_as_float(w.w & 0xffff0000u)}; }
                    const f32x4 x0 = b0 + gv[bj][0] * acc[ai][bj][m][0], x1 = b1 + gv[bj][1] * acc[ai][bj][m][1];
                    u32x4 o; o.x = cvt_pk_bf16(x0[0], x0[1]); o.y = cvt_pk_bf16(x0[2], x0[3]); o.z = cvt_pk_bf16(x1[0], x1[1]); o.w = cvt_pk_bf16(x1[2], x1[3]);
                    *(u32x4*)(out + off + bj * HALF) = o; } }
        }
    }
};
template <bool BASE_F32, bool FINAL>
struct EpiResidNorm {
    static constexpr bool PERM = true, AFTER_DRAIN = false;
    const void* base; bf16_t* xout; int ldc; const float* gt; int rows_per_batch;
    const float* g; const float* sh; const float* sc; bf16_t* h; float* fout;
    float* part; unsigned* cnt; PG8_LAS float* ls;
    __device__ __forceinline__ void operator()(const f32x4 (&acc)[2][2][4][2], const Unit& u, int wr, int wc, int fr, int fq) const {
#define PG8_LBAR() asm volatile("s_waitcnt lgkmcnt(0)\n\ts_barrier" ::: "memory")
        const int tid = launder_v((int)threadIdx.x);
        const int col0 = u.pn * BM + wc * 32 + 8 * fq; const int b = (u.pm * BM) / rows_per_batch;
        const int lrow = launder_v(wr * 64 + fr);
        f32x4 xv[2][2][4][2]; float ss[2][4];
        { f32x4 gv[2][2];
#pragma unroll
          for (int bj = 0; bj < 2; ++bj)
#pragma unroll
            for (int n = 0; n < 2; ++n) gv[bj][n] = *(const f32x4*)(gt + (size_t)b * 6144 + col0 + bj * HALF + 4 * n);
#pragma unroll
          for (int ai = 0; ai < 2; ++ai) {
            constexpr int MB = BASE_F32 ? 2 : 4;
#pragma unroll
            for (int m0 = 0; m0 < 4; m0 += MB) {
            u32x4 wb[MB][2]; f32x4 wf[MB][2][2];
#pragma unroll
            for (int mm = 0; mm < MB; ++mm) { const int m = m0 + mm; const size_t off = (size_t)(u.pm * BM + ai * HALF + wr * 64 + m * 16 + fr) * ldc + col0;
#pragma unroll
                for (int bj = 0; bj < 2; ++bj) {
                    if (BASE_F32) { wf[mm][bj][0] = *(const f32x4*)((const float*)base + off + bj * HALF); wf[mm][bj][1] = *(const f32x4*)((const float*)base + off + bj * HALF + 4); }
                    else wb[mm][bj] = *(const u32x4*)((const bf16_t*)base + off + bj * HALF); } }
#pragma unroll
            for (int mm = 0; mm < MB; ++mm) { const int m = m0 + mm; float s = 0.f;
#pragma unroll
                for (int bj = 0; bj < 2; ++bj) { f32x4 b0, b1;
                    if (BASE_F32) { b0 = wf[mm][bj][0]; b1 = wf[mm][bj][1]; }
                    else { const u32x4 w = wb[mm][bj];
                        b0 = (f32x4){__uint_as_float(w.x << 16), __uint_as_float(w.x & 0xffff0000u), __uint_as_float(w.y << 16), __uint_as_float(w.y & 0xffff0000u)};
                        b1 = (f32x4){__uint_as_float(w.z << 16), __uint_as_float(w.z & 0xffff0000u), __uint_as_float(w.w << 16), __uint_as_float(w.w & 0xffff0000u)}; }
                    const f32x4 x0 = b0 + gv[bj][0] * acc[ai][bj][m][0], x1 = b1 + gv[bj][1] * acc[ai][bj][m][1];
                    xv[ai][bj][m][0] = x0; xv[ai][bj][m][1] = x1;
                    s += (x0[0] * x0[0] + x0[1] * x0[1]) + (x0[2] * x0[2] + x0[3] * x0[3]) + (x1[0] * x1[0] + x1[1] * x1[1]) + (x1[2] * x1[2] + x1[3] * x1[3]); }
                s += __shfl_xor(s, 16); s += __shfl_xor(s, 32); ss[ai][m] = s; } } } }
        const int wid = tid >> 6, ln = tid & 63;
        if (fq == 0) {
#pragma unroll
            for (int ai = 0; ai < 2; ++ai)
#pragma unroll
                for (int m = 0; m < 4; ++m) ls[(ai * HALF + m * 16 + lrow) * 4 + wc] = ss[ai][m]; }
        PG8_LBAR();
        const int row = wid * 32 + (ln & 31);
        if (ln < 32) { const f32x4 p4 = *(const PG8_LAS f32x4*)(ls + row * 4);
            __hip_atomic_store(part + ((size_t)u.pm * 256 + row) * 4 + u.pn, (p4[0] + p4[1]) + (p4[2] + p4[3]), __ATOMIC_RELAXED, __HIP_MEMORY_SCOPE_AGENT); }
        asm volatile("s_waitcnt vmcnt(0)" ::: "memory");
        if (ln == 0) __hip_atomic_fetch_add(cnt + 16 * u.pm, 1u, __ATOMIC_RELAXED, __HIP_MEMORY_SCOPE_AGENT);
        if (!FINAL) {
#pragma unroll
            for (int bj = 0; bj < 2; ++bj)
#pragma unroll
                for (int ai = 0; ai < 2; ++ai)
#pragma unroll
                    for (int m = 0; m < 4; ++m) { const size_t off = (size_t)(u.pm * BM + ai * HALF + wr * 64 + m * 16 + fr) * ldc + col0 + bj * HALF;
                        const f32x4 x0 = xv[ai][bj][m][0], x1 = xv[ai][bj][m][1];
                        u32x4 o; o.x = cvt_pk_bf16(x0[0], x0[1]); o.y = cvt_pk_bf16(x0[2], x0[3]); o.z = cvt_pk_bf16(x1[0], x1[1]); o.w = cvt_pk_bf16(x1[2], x1[3]);
                        *(u32x4*)(xout + off) = o; } }
        if (wid == 0) {
            while ((unsigned)__builtin_amdgcn_readfirstlane(__hip_atomic_load(cnt + 16 * u.pm, __ATOMIC_RELAXED, __HIP_MEMORY_SCOPE_AGENT)) < 32u) { }
            __builtin_amdgcn_fence(__ATOMIC_ACQUIRE, "agent");
            asm volatile("s_waitcnt vmcnt(0)" ::: "memory"); }
        asm volatile("s_waitcnt lgkmcnt(0)\n\ts_barrier" ::: "memory");
        if (ln < 32) { const float* pp = part + ((size_t)u.pm * 256 + row) * 4;
            const float s = (__hip_atomic_load(pp, __ATOMIC_RELAXED, __HIP_MEMORY_SCOPE_AGENT) + __hip_atomic_load(pp + 1, __ATOMIC_RELAXED, __HIP_MEMORY_SCOPE_AGENT))
                          + (__hip_atomic_load(pp + 2, __ATOMIC_RELAXED, __HIP_MEMORY_SCOPE_AGENT) + __hip_atomic_load(pp + 3, __ATOMIC_RELAXED, __HIP_MEMORY_SCOPE_AGENT));
            ls[1024 + row] = rsqrtf(s * (1.f / 1024.f) + EPS); }
        PG8_LBAR();
        float rs[2][4];
#pragma unroll
        for (int ai = 0; ai < 2; ++ai)
#pragma unroll
            for (int m = 0; m < 4; ++m) rs[ai][m] = ls[1024 + ai * HALF + m * 16 + lrow];
#pragma unroll
        for (int bj = 0; bj < 2; ++bj) {
            const int c = col0 + bj * HALF;
            f32x4 gm0 = *(const f32x4*)(g + c), gm1 = *(const f32x4*)(g + c + 4), sh0 = (f32x4){0.f, 0.f, 0.f, 0.f}, sh1 = sh0;
            if (!FINAL) { const f32x4 s0 = *(const f32x4*)(sc + (size_t)b * 6144 + c), s1 = *(const f32x4*)(sc + (size_t)b * 6144 + c + 4);
                gm0 = gm0 * (1.f + s0); gm1 = gm1 * (1.f + s1); sh0 = *(const f32x4*)(sh + (size_t)b * 6144 + c); sh1 = *(const f32x4*)(sh + (size_t)b * 6144 + c + 4); }
#pragma unroll
            for (int ai = 0; ai < 2; ++ai)
#pragma unroll
                for (int m = 0; m < 4; ++m) { const size_t off = (size_t)(u.pm * BM + ai * HALF + wr * 64 + m * 16 + fr) * ldc + c;
                    const f32x4 x0 = xv[ai][bj][m][0], x1 = xv[ai][bj][m][1]; const float r = rs[ai][m];
                    if (FINAL) { *(f32x4*)(fout + off) = x0 * r * gm0; *(f32x4*)(fout + off + 4) = x1 * r * gm1; }
                    else { const f32x4 h0 = x0 * r * gm0 + sh0, h1 = x1 * r * gm1 + sh1;
                        u32x4 q; q.x = cvt_pk_bf16(h0[0], h0[1]); q.y = cvt_pk_bf16(h0[2], h0[3]); q.z = cvt_pk_bf16(h1[0], h1[1]); q.w = cvt_pk_bf16(h1[2], h1[3]);
                        *(u32x4*)(h + off) = q; } } }
#undef PG8_LBAR
    }
};

template <class Epi, class Sched, bool ALIGN_EPI = false, bool SP2 = false>
__device__ __forceinline__ void gemm_phase(PG8_LAS unsigned char* lds, const Gemm g, const Sched& S, const Epi& E) {
    const int tid = launder_v((int)threadIdx.x), wid = __builtin_amdgcn_readfirstlane(tid >> 6), lane = tid & 63, wr = wid >> 2, wc = wid & 3, fr = lane & 15, fq = lane >> 4;
    const int K = g.K, nt = K / BK;
    unsigned voffA[2], voffB[2];
#pragma unroll
    for (int i = 0; i < 2; ++i) { int R, C; stage_rc(tid * 16 + i * 8192, R, C); const int Rb = Epi::PERM ? ((R & ~31) + perm32(R & 31)) : R;
        voffA[i] = (unsigned)(R * K + C) * 2u; voffB[i] = (unsigned)(Rb * K + C) * 2u; }
    const size_t kstep = (size_t)(BK * 2);
    const size_t hstep = (size_t)HALF * K * 2;
    const size_t tstep = 2 * hstep;
    const unsigned ldsw = (unsigned)wid * 1024u;
    const int aoff = lds_byte(wr * 64 + fr, fq * 8), boff = lds_byte(wc * 32 + fr, fq * 8);
#define PG8_SA(b, h) (((b) * 2 + (h)) * HTB)
#define PG8_SB(b, h) ((4 + (b) * 2 + (h)) * HTB)
#define PG8_STAGE(bufoff, gbase, voff) do { _Pragma("unroll") for (int _i = 0; _i < 2; ++_i) \
        __builtin_amdgcn_global_load_lds((const unsigned*)((const char*)(gbase) + (voff)[_i]), (PG8_LAS unsigned*)(lds + (bufoff) + ldsw + _i * 8192), 16, 0, 0); } while (0)
#define PG8_LDA(dst, b, h) do { _Pragma("unroll") for (int m = 0; m < 4; ++m) _Pragma("unroll") for (int k = 0; k < 2; ++k) dst[m][k] = *(const PG8_LAS bf16x8*)(lds + PG8_SA(b, h) + aoff + m * 2048 + k * 1024); } while (0)
#define PG8_LDB(dst, b, h) do { _Pragma("unroll") for (int n = 0; n < 2; ++n) _Pragma("unroll") for (int k = 0; k < 2; ++k) dst[n][k] = *(const PG8_LAS bf16x8*)(lds + PG8_SB(b, h) + boff + n * 2048 + k * 1024); } while (0)
#define PG8_MMA(ai, bj, At, Bt) do { __builtin_amdgcn_s_setprio(1); _Pragma("unroll") for (int m = 0; m < 4; ++m) _Pragma("unroll") for (int n = 0; n < 2; ++n) _Pragma("unroll") for (int k = 0; k < 2; ++k) \
        acc[ai][bj][m][n] = __builtin_amdgcn_mfma_f32_16x16x32_bf16(Bt[n][k], At[m][k], acc[ai][bj][m][n], 0, 0, 0); __builtin_amdgcn_s_setprio(0); } while (0)
#define PG8_WAIT_V(n) asm volatile("s_waitcnt vmcnt(" #n ")" ::: "memory")
#define PG8_WAIT_L(n) asm volatile("s_waitcnt lgkmcnt(" #n ")" ::: "memory")
#define PG8_BAR __builtin_amdgcn_s_barrier()
#define PG8_SCHED __builtin_amdgcn_sched_barrier(0)
    Unit cur, nxt; int ui = 0;
    if (!S.next(0, cur)) return;
    f32x4 acc[2][2][4][2];
#pragma unroll
    for (int a = 0; a < 2; ++a)
#pragma unroll
        for (int b = 0; b < 2; ++b)
#pragma unroll
            for (int m = 0; m < 4; ++m)
#pragma unroll
                for (int n = 0; n < 2; ++n) acc[a][b][m][n] = (f32x4){0.f, 0.f, 0.f, 0.f};
    bf16x8 At[4][2], B0[2][2], B1[2][2];
    const char* cA = (const char*)g.A + (size_t)cur.pm * tstep; const char* cB = (const char*)g.Bt + (size_t)cur.pn * tstep;
    S.a_ready(cur);
    if constexpr (SP2) {
        PG8_STAGE(PG8_SB(0, 0), cB, voffB); PG8_STAGE(PG8_SB(0, 1), cB + hstep, voffB); PG8_STAGE(PG8_SA(0, 0), cA, voffA); PG8_STAGE(PG8_SA(0, 1), cA + hstep, voffA);
        if (wr == 1) PG8_BAR;
        PG8_WAIT_V(2); PG8_BAR;
        PG8_STAGE(PG8_SB(1, 0), cB + kstep, voffB); PG8_STAGE(PG8_SA(1, 0), cA + kstep, voffA); PG8_STAGE(PG8_SB(1, 1), cB + hstep + kstep, voffB);
        PG8_WAIT_V(6); PG8_BAR;
    } else {
        PG8_STAGE(PG8_SB(0, 0), cB, voffB); PG8_STAGE(PG8_SA(0, 0), cA, voffA); PG8_STAGE(PG8_SB(0, 1), cB + hstep, voffB); PG8_STAGE(PG8_SA(0, 1), cA + hstep, voffA);
        if (wr == 1) PG8_BAR;
        PG8_WAIT_V(4); PG8_BAR;
        PG8_STAGE(PG8_SB(1, 0), cB + kstep, voffB); PG8_STAGE(PG8_SA(1, 0), cA + kstep, voffA); PG8_STAGE(PG8_SB(1, 1), cB + hstep + kstep, voffB);
        PG8_WAIT_V(6); PG8_BAR;
    }
    for (;;) {
        const bool has_next = S.next(ui + 1, nxt);
        const char* nA = has_next ? (const char*)g.A + (size_t)nxt.pm * tstep : cA; const char* nB = has_next ? (const char*)g.Bt + (size_t)nxt.pn * tstep : cB;
        for (int t = 0; t < nt; t += 2) {
            const bool last = (t == nt - 2);
            const char* a1 = cA + (size_t)(t + 1) * kstep;
            const char* a2 = last ? nA : cA + (size_t)(t + 2) * kstep; const char* b2 = last ? nB : cB + (size_t)(t + 2) * kstep;
            const char* a3 = a2 + kstep; const char* b3 = b2 + kstep;
            if (last && has_next) S.a_ready(nxt);
            if constexpr (SP2) {
            PG8_LDB(B0, 0, 0); PG8_LDB(B1, 0, 1); PG8_SCHED; PG8_LDA(At, 0, 0); PG8_STAGE(PG8_SA(1, 1), a1 + hstep, voffA);
            PG8_WAIT_V(8); PG8_WAIT_L(0); PG8_BAR; PG8_MMA(0, 0, At, B0); PG8_MMA(0, 1, At, B1); PG8_BAR; PG8_SCHED;
            PG8_LDA(At, 0, 1); PG8_STAGE(PG8_SB(0, 0), b2, voffB); PG8_STAGE(PG8_SB(0, 1), b2 + hstep, voffB); PG8_STAGE(PG8_SA(0, 0), a2, voffA);
            PG8_WAIT_V(8); PG8_WAIT_L(0); PG8_BAR; PG8_MMA(1, 0, At, B0); PG8_MMA(1, 1, At, B1); PG8_BAR; PG8_SCHED;
            PG8_LDB(B0, 1, 0); PG8_LDB(B1, 1, 1); PG8_SCHED; PG8_LDA(At, 1, 0); PG8_STAGE(PG8_SA(0, 1), a2 + hstep, voffA);
            PG8_WAIT_V(8); PG8_WAIT_L(0); PG8_BAR; PG8_MMA(0, 0, At, B0); PG8_MMA(0, 1, At, B1); PG8_BAR; PG8_SCHED;
            PG8_LDA(At, 1, 1); PG8_STAGE(PG8_SB(1, 0), b3, voffB); PG8_STAGE(PG8_SB(1, 1), b3 + hstep, voffB); PG8_STAGE(PG8_SA(1, 0), a3, voffA);
            PG8_WAIT_V(8); PG8_WAIT_L(0); PG8_BAR; PG8_MMA(1, 0, At, B0); PG8_MMA(1, 1, At, B1); PG8_BAR; PG8_SCHED;
            } else {
            PG8_LDB(B0, 0, 0); PG8_SCHED; PG8_LDA(At, 0, 0); PG8_STAGE(PG8_SA(1, 1), a1 + hstep, voffA);
            PG8_WAIT_L(8); PG8_BAR; PG8_WAIT_L(0); PG8_MMA(0, 0, At, B0); PG8_BAR; PG8_SCHED;
            PG8_LDB(B1, 0, 1); PG8_STAGE(PG8_SB(0, 0), b2, voffB);
            PG8_BAR; PG8_WAIT_L(0); PG8_MMA(0, 1, At, B1); PG8_BAR;
            PG8_LDA(At, 0, 1); PG8_STAGE(PG8_SA(0, 0), a2, voffA);
            PG8_BAR; PG8_WAIT_L(0); PG8_MMA(1, 0, At, B0); PG8_BAR; PG8_SCHED;
            PG8_STAGE(PG8_SB(0, 1), b2 + hstep, voffB);
            PG8_WAIT_V(6); PG8_BAR; PG8_MMA(1, 1, At, B1); PG8_BAR;
            PG8_LDB(B0, 1, 0); PG8_SCHED; PG8_LDA(At, 1, 0); PG8_STAGE(PG8_SA(0, 1), a2 + hstep, voffA);
            PG8_WAIT_L(8); PG8_BAR; PG8_WAIT_L(0); PG8_MMA(0, 0, At, B0); PG8_BAR; PG8_SCHED;
            PG8_LDB(B1, 1, 1); PG8_STAGE(PG8_SB(1, 0), b3, voffB);
            PG8_BAR; PG8_WAIT_L(0); PG8_MMA(0, 1, At, B1); PG8_BAR;
            PG8_LDA(At, 1, 1); PG8_STAGE(PG8_SA(1, 0), a3, voffA);
            PG8_BAR; PG8_WAIT_L(0); PG8_MMA(1, 0, At, B0); PG8_BAR; PG8_SCHED;
            PG8_STAGE(PG8_SB(1, 1), b3 + hstep, voffB);
            PG8_WAIT_V(6); PG8_BAR; PG8_MMA(1, 1, At, B1); PG8_BAR;
            }
        }
        if constexpr (ALIGN_EPI) { if (wr == 0) PG8_BAR; }
        if constexpr (!Epi::AFTER_DRAIN) { E(acc, cur, wr, wc, fr, fq); S.done(cur); }
        if (!has_next) break;
#pragma unroll
        for (int a = 0; a < 2; ++a)
#pragma unroll
            for (int b = 0; b < 2; ++b)
#pragma unroll
                for (int m = 0; m < 4; ++m)
#pragma unroll
                    for (int n = 0; n < 2; ++n) acc[a][b][m][n] = (f32x4){0.f, 0.f, 0.f, 0.f};
        cur = nxt; cA = nA; cB = nB; ++ui;
        if constexpr (ALIGN_EPI) { if (wr == 1) PG8_BAR; }
    }
    PG8_WAIT_V(0);
    if constexpr (!ALIGN_EPI) { if (wr == 0) PG8_BAR; }
    PG8_BAR;
    if constexpr (Epi::AFTER_DRAIN) { E.fused(acc, cur, wr, wc, fr, fq, lds, wid, lane); S.done(cur); }
#undef PG8_SA
#undef PG8_SB
#undef PG8_STAGE
#undef PG8_LDA
#undef PG8_LDB
#undef PG8_MMA
#undef PG8_WAIT_V
#undef PG8_WAIT_L
#undef PG8_BAR
#undef PG8_SCHED
}
}

namespace att {
using bf16x8 = __attribute__((ext_vector_type(8))) short;
using s16x4 = __attribute__((ext_vector_type(4))) short;
using f32x16 = __attribute__((ext_vector_type(16))) float;
using u32x4 = __attribute__((ext_vector_type(4))) unsigned;
typedef short v4i16_t __attribute__((ext_vector_type(4)));
typedef __attribute__((address_space(3))) const char* lds_cptr;
constexpr int NW = 8, QB = 256, KVBLK = 64, NT = SEQ / KVBLK;
constexpr int NSLOT = 4, SLOTB = 8192;
constexpr int LDS_K = 0, LDS_V = NSLOT * SLOTB, LDS_WS = 2 * NSLOT * SLOTB, LDS_OST = LDS_WS + NW * 128 * 4, LDS_BYTES = LDS_OST + NW * 32 * 64 * 4;
__device__ __forceinline__ int crow(int r, int hi) { return (r & 3) + 8 * (r >> 2) + 4 * hi; }
__device__ __forceinline__ void glds16(const void* gsrc, unsigned lds_dst) { unsigned keep;
    asm volatile("s_mov_b32 %0, m0\n\ts_mov_b32 m0, %2\n\ts_nop 0\n\tglobal_load_lds_dwordx4 %1, off\n\ts_mov_b32 m0, %0" : "=&s"(keep) : "v"(gsrc), "s"(lds_dst) : "memory"); }
typedef float f32x2_t __attribute__((ext_vector_type(2))); typedef __bf16 bf16x2_t __attribute__((ext_vector_type(2)));
__device__ __forceinline__ unsigned cvtpk_s(float lo, float hi) { f32x2_t v = {lo, hi}; bf16x2_t b = __builtin_convertvector(v, bf16x2_t); return __builtin_bit_cast(unsigned, b); }
__device__ __forceinline__ s16x4 vtr(lds_cptr p) { return __builtin_bit_cast(s16x4, __builtin_amdgcn_ds_read_tr16_b64_v4i16((__attribute__((address_space(3))) v4i16_t*)p)); }
#define ATT_WAIT_BAR(N) asm volatile("s_waitcnt vmcnt(" #N ") lgkmcnt(0)\n\ts_barrier" ::: "memory")

__device__ __forceinline__ float max3f(float a, float b, float c) { float r; asm("v_max3_f32 %0, %1, %2, %3" : "=v"(r) : "v"(a), "v"(b), "v"(c)); return r; }
__device__ __forceinline__ float fadd_s(float a, float b) { float r; asm("v_add_f32_e32 %0, %1, %2" : "=v"(r) : "v"(a), "v"(b)); return r; }
__device__ __forceinline__ float max2f(float a, float b) { float r; asm("v_max_f32_e32 %0, %1, %2" : "=v"(r) : "v"(a), "v"(b)); return r; }
#define ATT_DIAG_BIAS(s0, s1) do { const float dqh_ = dq - (float)(4 * hi); _Pragma("unroll") for (int r = 0; r < 16; ++r) { const float c_ = (float)((r & 3) + 8 * (r >> 2)); \
        s0[r] = __builtin_fmaf(-sl, __builtin_fabsf(dqh_ - c_), s0[r]); s1[r] = __builtin_fmaf(-sl, __builtin_fabsf(dqh_ - (c_ + 32.f)), s1[r]); } } while (0)
template <bool FIRST>
__device__ __forceinline__ float softmax_exact(f32x16& s0, f32x16& s1, float& mhat, float& lreg, f32x16& o0, f32x16& o1, float* wsf_f, const int r32, const int hi) {
    float ra = max3f(s0[0], s0[1], s1[0]), rb = max3f(s0[2], s0[3], s1[1]); ra = max3f(ra, s1[2], s1[3]);
#pragma unroll
    for (int r = 4; r < 16; r += 4) { ra = max3f(ra, s0[r], s0[r + 1]); rb = max3f(rb, s0[r + 2], s0[r + 3]); ra = max3f(ra, s1[r], s1[r + 1]); rb = max3f(rb, s1[r + 2], s1[r + 3]); }
    float rm = max2f(ra, rb);
    { auto rr = __builtin_amdgcn_permlane32_swap(__float_as_uint(rm), __float_as_uint(rm), false, false); rm = max2f(__uint_as_float(rr[0]), __uint_as_float(rr[1])); }
    const float dl = FIRST ? rm : max2f(rm, 0.f);
    mhat += dl;
    if (!FIRST) {
        const float f = __builtin_amdgcn_exp2f(-dl); lreg *= f;
        if (hi == 0) wsf_f[r32] = f;
        asm volatile("s_waitcnt lgkmcnt(0)" ::: "memory");
#pragma unroll
        for (int r = 0; r < 16; ++r) { const float fr = wsf_f[crow(r, hi)]; o0[r] *= fr; o1[r] *= fr; }
        asm volatile("" ::: "memory");
    }
    float sacc = 0.f;
#pragma unroll
    for (int r = 0; r < 16; ++r) { s0[r] = __builtin_amdgcn_exp2f(s0[r] - dl); s1[r] = __builtin_amdgcn_exp2f(s1[r] - dl); sacc += s0[r] + s1[r]; }
    return sacc;
}
#define ATT_PIN(x) asm volatile("" : "+v"(x))
#define ATT_EXPSUM(s0, s1, acc) do { float c0_ = 0.f, c1_ = 0.f, c2_ = 0.f, c3_ = 0.f; \
    _Pragma("unroll") for (int r = 0; r < 16; r += 2) { s0[r] = __builtin_amdgcn_exp2f(s0[r]); s1[r] = __builtin_amdgcn_exp2f(s1[r]); s0[r + 1] = __builtin_amdgcn_exp2f(s0[r + 1]); s1[r + 1] = __builtin_amdgcn_exp2f(s1[r + 1]); \
        c0_ += s0[r]; ATT_PIN(c0_); c1_ += s1[r]; ATT_PIN(c1_); c2_ += s0[r + 1]; ATT_PIN(c2_); c3_ += s1[r + 1]; ATT_PIN(c3_); } \
    c0_ += c1_; ATT_PIN(c0_); c2_ += c3_; ATT_PIN(c2_); acc = c0_ + c2_; } while (0)
#define ATT_PACK(s0, s1, pw0, pw1, pw2, pw3) do { \
    pw0 = (u32x4){cvtpk_s(s0[0], s0[1]), cvtpk_s(s0[2], s0[3]), cvtpk_s(s0[4], s0[5]), cvtpk_s(s0[6], s0[7])}; \
    pw1 = (u32x4){cvtpk_s(s0[8], s0[9]), cvtpk_s(s0[10], s0[11]), cvtpk_s(s0[12], s0[13]), cvtpk_s(s0[14], s0[15])}; \
    pw2 = (u32x4){cvtpk_s(s1[0], s1[1]), cvtpk_s(s1[2], s1[3]), cvtpk_s(s1[4], s1[5]), cvtpk_s(s1[6], s1[7])}; \
    pw3 = (u32x4){cvtpk_s(s1[8], s1[9]), cvtpk_s(s1[10], s1[11]), cvtpk_s(s1[12], s1[13]), cvtpk_s(s1[14], s1[15])}; } while (0)
__device__ __forceinline__ float bfr(float x) { return __uint_as_float(cvtpk_s(x, 0.f) << 16); }
__device__ __forceinline__ bf16x8 make_qaug(const float a, const float sgs1, const unsigned w2, const unsigned h0, const unsigned h1, const int hi) {
    const float r1 = a - bfr(a), r2 = r1 - bfr(r1);
    u32x4 w; w.x = cvtpk_s(a, r1); w.y = cvtpk_s(r2, sgs1); w.z = w2; w.w = 0u;
    if (hi) { w.x = h0; w.y = h1; w.z = 0u; }
    return __builtin_bit_cast(bf16x8, w);
}

template <int THRL, int SKIP_T, int ABL = 0>
__device__ __forceinline__ void attn_unit(const int b, const int h, const int qb, const bf16_t* __restrict__ proj, bf16_t* __restrict__ mix, const float* __restrict__ gsub,
                                          const float lam, const float oscale, const unsigned* __restrict__ kn2, char* shm) {
    const int tid = launder_v((int)threadIdx.x), lane = tid & 63, r32 = lane & 31, hi = lane >> 5; const int wid = __builtin_amdgcn_readfirstlane(tid >> 6);
    const int grp = wid >> 2;
    const long rowbase = (long)b * SEQ; const int q0 = qb * QB;
    const float sl0 = __builtin_amdgcn_exp2f(-(float)(h + 1)) * LOG2E;
    const float s1 = bfr(sl0), s2 = bfr(sl0 - s1), s3 = bfr(sl0 - s1 - s2); const float sl = s1 + s2 + s3;
    const bf16_t* Qw = proj + (rowbase + q0 + wid * 32) * INW + O_Q + h * 64;
    const bf16_t* Kh = proj + rowbase * INW + O_K + h * 64; const bf16_t* Vh = proj + rowbase * INW + O_V + h * 64;
    const unsigned lds0 = (unsigned)(uintptr_t)shm;
    float* wsf = (float*)(shm + LDS_WS) + wid * 128;
    const bf16_t* ksrc = Kh + (long)(16 * (wid & 3) + (lane >> 2)) * INW + (wid >> 2) * 32 + (((lane & 3) ^ ((lane >> 4) & 3))) * 8;
    const bf16_t* vsrc = Vh + (long)(16 * (wid & 3) + (lane >> 2)) * INW + (wid >> 2) * 32 + (lane & 3) * 8;
    const unsigned kdst = lds0 + LDS_K + wid * 1024, vdst = lds0 + LDS_V + wid * 1024;
    const int d0t = 4 * qb;
    int nR = NT - d0t, NTe = NT;
    const int td = d0t + (wid >> 1);
#define ATT_TAU(i) ((i) < nR ? d0t + (i) : d0t - 1 - ((i) - nR))
#define ATT_DMA(i, slot) do { if (ABL & 1) break; const long off_ = (long)ATT_TAU(i) * KVBLK * INW; \
        glds16(ksrc + off_, (unsigned)__builtin_amdgcn_readfirstlane(kdst + (slot) * SLOTB)); glds16(vsrc + off_, (unsigned)__builtin_amdgcn_readfirstlane(vdst + (slot) * SLOTB)); } while (0)
#define ATT_BARV(N) do { if (ABL & 16) asm volatile("s_waitcnt vmcnt(" #N ") lgkmcnt(0)\n\ts_nop 11" ::: "memory"); else asm volatile("s_waitcnt vmcnt(" #N ") lgkmcnt(0)\n\ts_barrier\n\ts_nop 11" ::: "memory"); } while (0)
#define ATT_BAR() do { if (ABL & 16) asm volatile("s_waitcnt lgkmcnt(0)" ::: "memory"); else asm volatile("s_waitcnt lgkmcnt(0)\n\ts_barrier" ::: "memory"); } while (0)
#define ATT_SB() __builtin_amdgcn_sched_barrier(0)
    bf16x8 qr[4];
#pragma unroll
    for (int d0 = 0; d0 < 4; ++d0) qr[d0] = *reinterpret_cast<const bf16x8*>(&Qw[(long)r32 * INW + d0 * 16 + hi * 8]);
    float ka2 = 0.f, kb2 = 0.f;
    if (SKIP_T > 0) { const unsigned* knp = kn2 + ((b * 8 + h) * 2) * 64;
        ka2 = __uint_as_float(__hip_atomic_load(knp + lane, __ATOMIC_RELAXED, __HIP_MEMORY_SCOPE_AGENT)); kb2 = __uint_as_float(__hip_atomic_load(knp + 64 + lane, __ATOMIC_RELAXED, __HIP_MEMORY_SCOPE_AGENT)); }
    const bf16_t* Kq = Kh + (long)(q0 + wid * 32 + r32) * INW + hi * 8;
    bf16x8 kk[4];
    if (SKIP_T > 0) {
#pragma unroll
        for (int d0 = 0; d0 < 4; ++d0) kk[d0] = *reinterpret_cast<const bf16x8*>(Kq + d0 * 16); }
    ATT_DMA(0, 0); ATT_DMA(1, 1);
    float dra = 0.f, drb = 0.f;
    if (SKIP_T > 0) {
        float qa2 = 0.f, qb2 = 0.f;
#pragma unroll
        for (int d0 = 0; d0 < 4; ++d0) {
#pragma unroll
            for (int j = 0; j < 8; ++j) { const float qv = bf2f((bf16_t)qr[d0][j]), kv = bf2f((bf16_t)kk[d0][j]); if (d0 < 2) { qa2 += qv * qv; dra += qv * kv; } else { qb2 += qv * qv; drb += qv * kv; } } }
        qa2 += __shfl_xor(qa2, 32); qb2 += __shfl_xor(qb2, 32); dra += __shfl_xor(dra, 32); drb += __shfl_xor(drb, 32);
#pragma unroll
        for (int o = 1; o < 32; o <<= 1) { qa2 = fmaxf(qa2, __shfl_xor(qa2, o)); qb2 = fmaxf(qb2, __shfl_xor(qb2, o)); }
        if (lane == 0) { wsf[0] = qa2; wsf[1] = qb2; }
    }
    { __attribute__((address_space(3))) bf16x8* qst_ = (__attribute__((address_space(3))) bf16x8*)((lds_cptr)shm + LDS_OST + wid * 8192) + lane;
#pragma unroll
      for (int d0 = 0; d0 < 4; ++d0) qst_[d0 * 64] = qr[d0]; }
    const lds_cptr qp = (lds_cptr)shm + LDS_OST + wid * 8192 + lane * 16;
#define ATT_LDQ() const bf16x8 qf0 = *(const __attribute__((address_space(3))) bf16x8*)(qp), qf1 = *(const __attribute__((address_space(3))) bf16x8*)(qp + 1024), qf2 = *(const __attribute__((address_space(3))) bf16x8*)(qp + 2048), qf3 = *(const __attribute__((address_space(3))) bf16x8*)(qp + 3072)
    bf16x8 kaug0, kaug1;
    { const unsigned sb0 = (unsigned)f2bf((float)r32), sb1 = (unsigned)f2bf((float)(r32 + 32));
      u32x4 w0 = (u32x4){0x3F803F80u, (sb0 << 16) | 0x3F80u, (sb0 << 16) | sb0, 0u}, w1 = (u32x4){0x3F803F80u, (sb1 << 16) | 0x3F80u, (sb1 << 16) | sb1, 0u};
      if (hi) { w0 = (u32x4){0u, 0u, 0u, 0u}; w1 = w0; }
      kaug0 = __builtin_bit_cast(bf16x8, w0); kaug1 = __builtin_bit_cast(bf16x8, w1); }
    const unsigned w2pos = cvtpk_s(s2, s3), w2neg = cvtpk_s(-s2, -s3), h0pos = cvtpk_s(s1, s2), h0neg = cvtpk_s(-s1, -s2), h1pos = cvtpk_s(s3, 0.f), h1neg = cvtpk_s(-s3, 0.f);
    float mhatA = 0.f, mhatB = 0.f, lA = 0.f, lB = 0.f;
    f32x16 oa0 = f32x16{}, oa1 = f32x16{}, ob0 = f32x16{}, ob1 = f32x16{};
    f32x16 sa0, sa1, sb0, sb1;
    u32x4 pa0, pa1, pa2, pa3, pb0, pb1, pb2, pb3;
    bf16x8 qaA, qaB;
    const lds_cptr shm3 = (lds_cptr)shm;
    const lds_cptr kp0 = (lds_cptr)shm + LDS_K + (r32 >> 4) * 1024 + (r32 & 15) * 64 + ((hi) ^ ((r32 >> 2) & 3)) * 16;
    const int koB = (((2 + hi) ^ ((r32 >> 2) & 3)) - ((hi) ^ ((r32 >> 2) & 3))) * 16;
    const lds_cptr vp0 = shm3 + LDS_V + ((lane >> 4) & 1) * 32 + (lane & 3) * 8 + (4 * hi + ((lane & 15) >> 2)) * 64;
    const int tq = q0 + wid * 32 + r32;
    const f32x16 zero = f32x16{};
#define ATT_KA(off) (*(const __attribute__((address_space(3))) bf16x8*)(kp + (off)))
#define ATT_KB(off) (*(const __attribute__((address_space(3))) bf16x8*)(kp + koB + (off)))
#define ATT_VFR(n, ks) const s16x4 l0##n = vtr(vp + (ks) * 1024), h0##n = vtr(vp + (ks) * 1024 + 512), l1##n = vtr(vp + 4096 + (ks) * 1024), h1##n = vtr(vp + 4096 + (ks) * 1024 + 512)
#define ATT_PVK(n, PA, PB) do { if (ABL & 4) { asm volatile("" :: "v"(l0##n), "v"(h0##n), "v"(l1##n), "v"(h1##n), "v"(PA), "v"(PB)); break; } const bf16x8 v0_ = (bf16x8){l0##n[0], l0##n[1], l0##n[2], l0##n[3], h0##n[0], h0##n[1], h0##n[2], h0##n[3]}, v1_ = (bf16x8){l1##n[0], l1##n[1], l1##n[2], l1##n[3], h1##n[0], h1##n[1], h1##n[2], h1##n[3]}; \
        const bf16x8 pa_ = __builtin_bit_cast(bf16x8, PA), pb_ = __builtin_bit_cast(bf16x8, PB); \
        oa0 = __builtin_amdgcn_mfma_f32_32x32x16_bf16(pa_, v0_, oa0, 0, 0, 0); oa1 = __builtin_amdgcn_mfma_f32_32x32x16_bf16(pa_, v1_, oa1, 0, 0, 0); \
        ob0 = __builtin_amdgcn_mfma_f32_32x32x16_bf16(pb_, v0_, ob0, 0, 0, 0); ob1 = __builtin_amdgcn_mfma_f32_32x32x16_bf16(pb_, v1_, ob1, 0, 0, 0); } while (0)
#define ATT_QKA() do { if (ABL & 8) { asm volatile("" : "+v"(sa0), "+v"(sa1) : "v"(ka0), "v"(ka1), "v"(ka2), "v"(ka3), "v"(qaA)); break; } sa0 = __builtin_amdgcn_mfma_f32_32x32x16_bf16(kaug0, qaA, zero, 0, 0, 0); sa1 = __builtin_amdgcn_mfma_f32_32x32x16_bf16(kaug1, qaA, zero, 0, 0, 0); \
        sa0 = __builtin_amdgcn_mfma_f32_32x32x16_bf16(ka0, qf0, sa0, 0, 0, 0); sa1 = __builtin_amdgcn_mfma_f32_32x32x16_bf16(ka1, qf0, sa1, 0, 0, 0); \
        sa0 = __builtin_amdgcn_mfma_f32_32x32x16_bf16(ka2, qf1, sa0, 0, 0, 0); sa1 = __builtin_amdgcn_mfma_f32_32x32x16_bf16(ka3, qf1, sa1, 0, 0, 0); } while (0)
#define ATT_QKB() do { if (ABL & 8) { asm volatile("" : "+v"(sb0), "+v"(sb1) : "v"(kb0), "v"(kb1), "v"(kb2), "v"(kb3), "v"(qaB)); break; } sb0 = __builtin_amdgcn_mfma_f32_32x32x16_bf16(kaug0, qaB, zero, 0, 0, 0); sb1 = __builtin_amdgcn_mfma_f32_32x32x16_bf16(kaug1, qaB, zero, 0, 0, 0); \
        sb0 = __builtin_amdgcn_mfma_f32_32x32x16_bf16(kb0, qf2, sb0, 0, 0, 0); sb1 = __builtin_amdgcn_mfma_f32_32x32x16_bf16(kb1, qf2, sb1, 0, 0, 0); \
        sb0 = __builtin_amdgcn_mfma_f32_32x32x16_bf16(kb2, qf3, sb0, 0, 0, 0); sb1 = __builtin_amdgcn_mfma_f32_32x32x16_bf16(kb3, qf3, sb1, 0, 0, 0); } while (0)
#define ATT_SIDE(tau_) ((tau_) < td ? 0 : ((tau_) == td ? 1 : 2))
#define ATT_QAUG(sd_) do { const bool left_ = (sd_) == 0, diag_ = (sd_) == 1; const float tsl = sl * (float)tq;     \
        const float aA_ = diag_ ? -mhatA : (left_ ? -tsl - mhatA : tsl - mhatA), aB_ = diag_ ? -mhatB : (left_ ? -tsl - mhatB : tsl - mhatB); \
        const float sgs1_ = diag_ ? 0.f : (left_ ? s1 : -s1); const unsigned w2_ = diag_ ? 0u : (left_ ? w2pos : w2neg), h0_ = diag_ ? 0u : (left_ ? h0pos : h0neg), h1_ = diag_ ? 0u : (left_ ? h1pos : h1neg); \
        qaA = make_qaug(aA_, sgs1_, w2_, h0_, h1_, hi); qaB = make_qaug(aB_, sgs1_, w2_, h0_, h1_, hi); } while (0)
#define ATT_KAUG(tau_) do { const unsigned tb_ = __float_as_uint((float)((tau_) * KVBLK)) >> 16; \
        if (hi) { const u32x4 w_ = (u32x4){tb_ | (tb_ << 16), tb_, 0u, 0u}; kaug0 = __builtin_bit_cast(bf16x8, w_); kaug1 = kaug0; } } while (0)
    ATT_QAUG(ATT_SIDE(d0t)); ATT_KAUG(d0t);
    ATT_BARV(2);
    { ATT_DMA(2, 2);
      const lds_cptr kp = kp0;
      const bf16x8 ka0 = ATT_KA(0), ka1 = ATT_KA(2048), ka2 = ATT_KB(0), ka3 = ATT_KB(2048), kb0 = ATT_KA(4096), kb1 = ATT_KA(6144), kb2 = ATT_KB(4096), kb3 = ATT_KB(6144);
      ATT_LDQ();
      ATT_QKA(); ATT_QKB();
      ATT_SB(); ATT_BARV(2); ATT_SB();
      const bool diag = d0t == td; const float dq = (float)(tq - d0t * KVBLK);
      if (ABL & 2) { asm volatile("" : "=v"(pa0), "=v"(pa1), "=v"(pa2), "=v"(pa3), "=v"(pb0), "=v"(pb1), "=v"(pb2), "=v"(pb3) : "v"(sa0), "v"(sa1), "v"(sb0), "v"(sb1)); } else {
      if (diag) { ATT_DIAG_BIAS(sa0, sa1); ATT_DIAG_BIAS(sb0, sb1); }
      lA = softmax_exact<true>(sa0, sa1, mhatA, lA, oa0, oa1, wsf, r32, hi); lB = softmax_exact<true>(sb0, sb1, mhatB, lB, ob0, ob1, wsf + 32, r32, hi);
      if (SKIP_T > 0) { float la = fmaxf(mhatA, dra), lb = fmaxf(mhatB, drb);
#pragma unroll
          for (int o = 1; o < 32; o <<= 1) { la = fminf(la, __shfl_xor(la, o)); lb = fminf(lb, __shfl_xor(lb, o)); }
          if (lane == 0) { wsf[2] = la; wsf[3] = lb; } }
      ATT_PACK(sa0, sa1, pa0, pa1, pa2, pa3); ATT_PACK(sb0, sb1, pb0, pb1, pb2, pb3); }
      { const int tn_ = ATT_TAU(1); ATT_QAUG(ATT_SIDE(tn_)); ATT_KAUG(tn_); }
      ATT_SB(); ATT_BAR(); ATT_SB(); }
    if (SKIP_T > 0) {
        float qa2 = 0.f, qb2 = 0.f, da = 3.0e38f, db = 3.0e38f;
        { const float* wall = (const float*)(shm + LDS_WS);
#pragma unroll
          for (int w = 0; w < NW; ++w) { qa2 = fmaxf(qa2, wall[w * 128 + 0]); qb2 = fmaxf(qb2, wall[w * 128 + 1]); da = fminf(da, wall[w * 128 + 2]); db = fminf(db, wall[w * 128 + 3]); } }
        const int kt0 = lane * KVBLK; const int dmin = kt0 + KVBLK - 1 < q0 ? q0 - (kt0 + KVBLK - 1) : (kt0 > q0 + QB - 1 ? kt0 - (q0 + QB - 1) : 0);
        const float pen = sl * (float)dmin - (float)SKIP_T;
        const bool needed = dmin == 0 || !(sqrtf(qa2 * ka2) * 1.01f - pen <= da) || !(sqrtf(qb2 * kb2) * 1.01f - pen <= db);
        const unsigned long long mask = __ballot(needed);
        const int tR = 63 - __clzll((long long)mask), tL = __ffsll((long long)mask) - 1;
        nR = __builtin_amdgcn_readfirstlane(tR + 1 - d0t); NTe = __builtin_amdgcn_readfirstlane(tR - tL + 1);
        ATT_BAR();
    }
    if (grp == 1) { ATT_BAR(); }
    for (int i = 1; i < NTe; ++i) {
        const int tau = ATT_TAU(i), slot = i & 3;
        { const int id_ = i + 2 < NTe ? i + 2 : NTe - 1; ATT_DMA(id_, (i + 2) & 3); }
        { const lds_cptr vp = vp0 + ((i - 1) & 3) * SLOTB, kp = kp0 + slot * SLOTB;
          ATT_VFR(a, 0); ATT_VFR(b, 1);
          const bf16x8 ka0 = ATT_KA(0), ka1 = ATT_KA(2048), ka2 = ATT_KB(0), ka3 = ATT_KB(2048);
          ATT_SB();
          ATT_PVK(a, pa0, pb0); ATT_SB();
          ATT_VFR(c, 2); ATT_SB();
          ATT_PVK(b, pa1, pb1); ATT_SB();
          ATT_VFR(d, 3);
          const bf16x8 kb0 = ATT_KA(4096), kb1 = ATT_KA(6144), kb2 = ATT_KB(4096), kb3 = ATT_KB(6144);
          ATT_LDQ();
          ATT_SB();
          ATT_PVK(c, pa2, pb2); ATT_SB();
          ATT_PVK(d, pa3, pb3); ATT_SB();
          ATT_QKA(); ATT_QKB(); }
        ATT_SB();
        ATT_BARV(2);
        __builtin_amdgcn_s_setprio(1);
        ATT_SB();
        { const bool diag = tau == td; const float dq = (float)(tq - tau * KVBLK);
          if (ABL & 2) { asm volatile("" : "=v"(pa0), "=v"(pa1), "=v"(pa2), "=v"(pa3), "=v"(pb0), "=v"(pb1), "=v"(pb2), "=v"(pb3) : "v"(sa0), "v"(sa1), "v"(sb0), "v"(sb1)); } else {
          if (diag) { ATT_DIAG_BIAS(sa0, sa1); ATT_DIAG_BIAS(sb0, sb1); }
          const float big = (float)(1u << THRL);
          bool redo = false;
          { float accA; ATT_EXPSUM(sa0, sa1, accA);
            if (__builtin_expect(__any(!(accA < big)), 0)) { const lds_cptr kp = kp0 + slot * SLOTB;
                const bf16x8 ka0 = ATT_KA(0), ka1 = ATT_KA(2048), ka2 = ATT_KB(0), ka3 = ATT_KB(2048);
                ATT_LDQ();
                ATT_QKA(); asm volatile("s_nop 15\n\ts_nop 7" : "+v"(sa0), "+v"(sa1)); if (diag) ATT_DIAG_BIAS(sa0, sa1);
                accA = softmax_exact<false>(sa0, sa1, mhatA, lA, oa0, oa1, wsf, r32, hi); redo = true; }
            lA += accA; ATT_PACK(sa0, sa1, pa0, pa1, pa2, pa3); }
          ATT_SB();
          { float accB; ATT_EXPSUM(sb0, sb1, accB);
            if (__builtin_expect(__any(!(accB < big)), 0)) { const lds_cptr kp = kp0 + slot * SLOTB;
                const bf16x8 kb0 = ATT_KA(4096), kb1 = ATT_KA(6144), kb2 = ATT_KB(4096), kb3 = ATT_KB(6144);
                ATT_LDQ();
                ATT_QKB(); asm volatile("s_nop 15\n\ts_nop 7" : "+v"(sb0), "+v"(sb1)); if (diag) ATT_DIAG_BIAS(sb0, sb1);
                accB = softmax_exact<false>(sb0, sb1, mhatB, lB, ob0, ob1, wsf + 32, r32, hi); redo = true; }
            lB += accB; ATT_PACK(sb0, sb1, pb0, pb1, pb2, pb3); }
          { const int in_ = i + 1 < NTe ? i + 1 : i; const int tn_ = ATT_TAU(in_); const int sdn_ = ATT_SIDE(tn_);
            if (redo || sdn_ != ATT_SIDE(tau)) { ATT_QAUG(sdn_); }
            ATT_KAUG(tn_); } } }
        __builtin_amdgcn_s_setprio(0);
        ATT_SB(); ATT_BAR(); ATT_SB();
    }
    { const lds_cptr vp = vp0 + ((NTe - 1) & 3) * SLOTB;
      ATT_VFR(a, 0); ATT_VFR(b, 1); ATT_VFR(c, 2); ATT_VFR(d, 3);
      ATT_PVK(a, pa0, pb0); ATT_PVK(b, pa1, pb1); ATT_PVK(c, pa2, pb2); ATT_PVK(d, pa3, pb3); }
    ATT_BAR();
    if (grp == 0) { ATT_BAR(); }
    { auto rr = __builtin_amdgcn_permlane32_swap(__float_as_uint(lA), __float_as_uint(lA), false, false); lA = __uint_as_float(rr[0]) + __uint_as_float(rr[1]); }
    { auto rr = __builtin_amdgcn_permlane32_swap(__float_as_uint(lB), __float_as_uint(lB), false, false); lB = __uint_as_float(rr[0]) + __uint_as_float(rr[1]); }
    if (hi == 0) { wsf[64 + r32] = 1.f / lA; wsf[96 + r32] = lam / lB; }
    asm volatile("s_waitcnt lgkmcnt(0)" ::: "memory");
    float* stg = (float*)(shm + LDS_OST) + wid * 2048;
#pragma unroll
    for (int r = 0; r < 16; ++r) { const int orow = crow(r, hi); const float a = wsf[64 + orow], c = wsf[96 + orow];
        stg[orow * 64 + r32] = oa0[r] * a - ob0[r] * c; stg[orow * 64 + 32 + r32] = oa1[r] * a - ob1[r] * c; }
    asm volatile("s_waitcnt lgkmcnt(0)" ::: "memory");
    bf16_t* Ow = mix + (rowbase + q0 + wid * 32) * D + h * 64;
    const int ch = lane & 7;
    const float4 g0 = *(const float4*)(gsub + ch * 8), g1 = *(const float4*)(gsub + ch * 8 + 4);
#pragma unroll
    for (int i = 0; i < 4; ++i) { const int row = i * 8 + (lane >> 3);
        const float4 a = *(const float4*)(stg + row * 64 + ch * 8), c = *(const float4*)(stg + row * 64 + ch * 8 + 4);
        float ss = a.x * a.x + a.y * a.y + a.z * a.z + a.w * a.w + c.x * c.x + c.y * c.y + c.z * c.z + c.w * c.w;
        ss += __shfl_xor(ss, 1); ss += __shfl_xor(ss, 2); ss += __shfl_xor(ss, 4);
        const float rn = rsqrtf(ss * (1.f / 64.f) + EPS) * oscale;
        u32x4 w; w.x = cvtpk_s(a.x * rn * g0.x, a.y * rn * g0.y); w.y = cvtpk_s(a.z * rn * g0.z, a.w * rn * g0.w); w.z = cvtpk_s(c.x * rn * g1.x, c.y * rn * g1.y); w.w = cvtpk_s(c.z * rn * g1.z, c.w * rn * g1.w);
        *(u32x4*)(Ow + (long)row * D + ch * 8) = w; }
    asm volatile("s_waitcnt lgkmcnt(0)" ::: "memory");
#undef ATT_TAU
#undef ATT_DMA
#undef ATT_BARV
#undef ATT_BAR
#undef ATT_SB
#undef ATT_KA
#undef ATT_KB
#undef ATT_LDQ
#undef ATT_VFR
#undef ATT_PVK
#undef ATT_QKA
#undef ATT_QKB
#undef ATT_QAUG
#undef ATT_KAUG
#undef ATT_SIDE
}
#undef ATT_WAIT_BAR
#undef ATT_DIAG_BIAS
#undef ATT_PACK
#undef ATT_EXPSUM
#undef ATT_PIN
}

constexpr int NWAVES = 8, NTHR = NWAVES * 64;
constexpr int RING_BYTES = 139264;
constexpr int MISC_OFF = RING_BYTES;
constexpr int LDS_BYTES = 147456;
static_assert(MISC_OFF + 128 <= LDS_BYTES && att::LDS_BYTES <= RING_BYTES, "LDS map");

__device__ __forceinline__ float wave_sum(float v) {
#pragma unroll
    for (int o = 1; o < 64; o <<= 1) v += __shfl_xor(v, o);
    return v;
}
__device__ __forceinline__ void p0_transpose_item(const float* __restrict__ W, int K, int N, bf16_t* __restrict__ WT, int k0, int n0, int dst_row0, LAS float* scr, int lane) {
    float4 v[16]; const int kr = lane >> 4, c4 = (lane & 15) * 4;
#pragma unroll
    for (int i = 0; i < 16; ++i) v[i] = *(const float4*)(W + (size_t)(k0 + 4 * i + kr) * N + n0 + c4);
#pragma unroll
    for (int i = 0; i < 16; ++i) { LAS float* d = scr + (4 * i + kr) * 65 + c4; d[0] = v[i].x; d[1] = v[i].y; d[2] = v[i].z; d[3] = v[i].w; }
    LDS_WAIT(); asm volatile("" ::: "memory");
    const int c = lane & 7;
#pragma unroll
    for (int j = 0; j < 8; ++j) { const int n = (lane >> 3) + 8 * j; const LAS float* s = scr + (8 * c) * 65 + n;
        uint4 o; o.x = pk2(s[0 * 65], s[1 * 65]); o.y = pk2(s[2 * 65], s[3 * 65]); o.z = pk2(s[4 * 65], s[5 * 65]); o.w = pk2(s[6 * 65], s[7 * 65]);
        *(uint4*)(WT + (size_t)(dst_row0 + n) * K + k0 + 8 * c) = o; }
    LDS_WAIT(); asm volatile("" ::: "memory");
}
__device__ __forceinline__ void p0_transpose_matrix(const float* W, int K, int N, bf16_t* WT, bool interleave, LAS float* scr, int gw, int ngw, int lane, int& cursor) {
    const int nkb = K / 64, nnb = N / 64, nitems = nkb * nnb;
    int first = ((gw - cursor) % ngw + ngw) % ngw;
    for (int it = first; it < nitems; it += ngw) { const int kb = it / nnb, nb = it % nnb; const int n0 = nb * 64;
        int dr = n0; if (interleave) { const int j = n0 < DFF ? n0 : n0 - DFF; dr = (j / 128) * 256 + (j % 128) + (n0 < DFF ? 0 : 128); }
        p0_transpose_item(W, K, N, WT, kb * 64, n0, dr, scr, lane); }
    cursor += nitems;
}
__device__ __forceinline__ void p0_mod_unit(const float* __restrict__ c, const float* __restrict__ w_ada, const float* __restrict__ b_ada, float* __restrict__ mod, int unit, LAS float* lds, int tid) {
    LAS float* sc = lds;
    LAS float* red = lds + 8192;
    const int l = unit / 96, j0 = (unit % 96) * 64, col = tid & 63, kq = tid >> 6;
    for (int i = tid; i < 8192; i += NTHR) { const float v = c[i]; sc[i] = v / (1.f + __expf(-v)); }
    __syncthreads();
    float acc[8] = {0.f, 0.f, 0.f, 0.f, 0.f, 0.f, 0.f, 0.f};
    const float* w = w_ada + (size_t)l * 1024 * 6144 + j0 + col;
    for (int k = kq * 128; k < kq * 128 + 128; k += 16) { float wv[16];
#pragma unroll
        for (int j = 0; j < 16; ++j) wv[j] = w[(size_t)(k + j) * 6144];
#pragma unroll
        for (int j = 0; j < 16; ++j)
#pragma unroll
            for (int b = 0; b < 8; ++b) acc[b] += sc[b * 1024 + k + j] * wv[j]; }
#pragma unroll
    for (int b = 0; b < 8; ++b) red[(kq * 8 + b) * 64 + col] = acc[b];
    __syncthreads();
    { const int b = kq; float s = b_ada[l * 6144 + j0 + col];
#pragma unroll
      for (int q = 0; q < 8; ++q) s += red[(q * 8 + b) * 64 + col];
      mod[((size_t)l * 8 + b) * 6144 + j0 + col] = s; }
    __syncthreads();
}
template <bool XF32, bool MOD, int NR>
__device__ __forceinline__ void norm_rows(const void* __restrict__ x0, const float* __restrict__ g, const float* __restrict__ sh, const float* __restrict__ sc, bf16_t* h0, float* f0, int lane) {
    const int c0 = lane * 16;
    float gm[16], shv[16];
#pragma unroll
    for (int j = 0; j < 4; ++j) { const float4 gv = *(const float4*)(g + c0 + 4 * j); gm[4 * j] = gv.x; gm[4 * j + 1] = gv.y; gm[4 * j + 2] = gv.z; gm[4 * j + 3] = gv.w;
        if (MOD) { const float4 s4 = *(const float4*)(sc + c0 + 4 * j), h4 = *(const float4*)(sh + c0 + 4 * j);
            gm[4 * j] *= 1.f + s4.x; gm[4 * j + 1] *= 1.f + s4.y; gm[4 * j + 2] *= 1.f + s4.z; gm[4 * j + 3] *= 1.f + s4.w; shv[4 * j] = h4.x; shv[4 * j + 1] = h4.y; shv[4 * j + 2] = h4.z; shv[4 * j + 3] = h4.w; } }
    float4 xf[XF32 ? NR : 1][4]; uint4 xh[XF32 ? 1 : NR][2];
#pragma unroll
    for (int r = 0; r < NR; ++r) {
        if (XF32) { const float4* xr = (const float4*)((const float*)x0 + (size_t)r * D) + lane * 4;
#pragma unroll
            for (int j = 0; j < 4; ++j) xf[r][j] = xr[j]; }
        else { const uint4* xr = (const uint4*)((const bf16_t*)x0 + (size_t)r * D) + lane * 2; xh[r][0] = xr[0]; xh[r][1] = xr[1]; } }
#pragma unroll
    for (int r = 0; r < NR; ++r) {
        float v[16];
        if (XF32) {
#pragma unroll
            for (int j = 0; j < 4; ++j) { v[4 * j] = xf[r][j].x; v[4 * j + 1] = xf[r][j].y; v[4 * j + 2] = xf[r][j].z; v[4 * j + 3] = xf[r][j].w; } }
        else {
#pragma unroll
            for (int j = 0; j < 2; ++j) { const uint4 t = xh[r][j];
                v[8 * j] = __uint_as_float(t.x << 16); v[8 * j + 1] = __uint_as_float(t.x & 0xffff0000u); v[8 * j + 2] = __uint_as_float(t.y << 16); v[8 * j + 3] = __uint_as_float(t.y & 0xffff0000u);
                v[8 * j + 4] = __uint_as_float(t.z << 16); v[8 * j + 5] = __uint_as_float(t.z & 0xffff0000u); v[8 * j + 6] = __uint_as_float(t.w << 16); v[8 * j + 7] = __uint_as_float(t.w & 0xffff0000u); } }
        float s = 0.f;
#pragma unroll
        for (int j = 0; j < 16; ++j) s += v[j] * v[j];
        const float rs = rsqrtf(wave_sum(s) * (1.f / D) + EPS);
        if (MOD) { uint4 w0, w1;
            w0.x = pk2(v[0] * rs * gm[0] + shv[0], v[1] * rs * gm[1] + shv[1]); w0.y = pk2(v[2] * rs * gm[2] + shv[2], v[3] * rs * gm[3] + shv[3]);
            w0.z = pk2(v[4] * rs * gm[4] + shv[4], v[5] * rs * gm[5] + shv[5]); w0.w = pk2(v[6] * rs * gm[6] + shv[6], v[7] * rs * gm[7] + shv[7]);
            w1.x = pk2(v[8] * rs * gm[8] + shv[8], v[9] * rs * gm[9] + shv[9]); w1.y = pk2(v[10] * rs * gm[10] + shv[10], v[11] * rs * gm[11] + shv[11]);
            w1.z = pk2(v[12] * rs * gm[12] + shv[12], v[13] * rs * gm[13] + shv[13]); w1.w = pk2(v[14] * rs * gm[14] + shv[14], v[15] * rs * gm[15] + shv[15]);
            uint4* hp = (uint4*)(h0 + (size_t)r * D + c0); hp[0] = w0; hp[1] = w1; }
        else { float4* fp = (float4*)(f0 + (size_t)r * D + c0);
#pragma unroll
            for (int j = 0; j < 4; ++j) fp[j] = make_float4(v[4 * j] * rs * gm[4 * j], v[4 * j + 1] * rs * gm[4 * j + 1], v[4 * j + 2] * rs * gm[4 * j + 2], v[4 * j + 3] * rs * gm[4 * j + 3]); }
    }
}
constexpr int POOL_UP = 528;
template <int HW>
__device__ __forceinline__ void pool_afr(const LAS unsigned char* base, const float inv, __attribute__((ext_vector_type(8))) short (&afr)[4]) {
    typedef unsigned ux4 __attribute__((ext_vector_type(4))); typedef __attribute__((ext_vector_type(8))) short bfx8;
#pragma unroll
    for (int ks = 0; ks < 4; ++ks) {
        float acc[8] = {0.f, 0.f, 0.f, 0.f, 0.f, 0.f, 0.f, 0.f};
#pragma unroll
        for (int o = -HW; o < HW; ++o) { const ux4 v = *(const LAS ux4*)(base + o * POOL_UP + ks * 32);
            acc[0] += __uint_as_float(v.x << 16); acc[1] += __uint_as_float(v.x & 0xffff0000u); acc[2] += __uint_as_float(v.y << 16); acc[3] += __uint_as_float(v.y & 0xffff0000u);
            acc[4] += __uint_as_float(v.z << 16); acc[5] += __uint_as_float(v.z & 0xffff0000u); acc[6] += __uint_as_float(v.w << 16); acc[7] += __uint_as_float(v.w & 0xffff0000u); }
        const ux4 c = *(const LAS ux4*)(base + ks * 32);
        ux4 w; w.x = pk2(acc[0] * inv - __uint_as_float(c.x << 16), acc[1] * inv - __uint_as_float(c.x & 0xffff0000u)); w.y = pk2(acc[2] * inv - __uint_as_float(c.y << 16), acc[3] * inv - __uint_as_float(c.y & 0xffff0000u));
        w.z = pk2(acc[4] * inv - __uint_as_float(c.z << 16), acc[5] * inv - __uint_as_float(c.z & 0xffff0000u)); w.w = pk2(acc[6] * inv - __uint_as_float(c.w << 16), acc[7] * inv - __uint_as_float(c.w & 0xffff0000u));
        afr[ks] = __builtin_bit_cast(bfx8, w);
    }
}
__device__ __forceinline__ void poolconv_rows(const bf16_t* __restrict__ proj, bf16_t* __restrict__ mix, const bf16_t* __restrict__ wpT, const float* __restrict__ pool_scale, const float* __restrict__ conv_w,
                                              int R0, LAS unsigned char* lds, int tid) {
    typedef __attribute__((ext_vector_type(8))) short bfx8; typedef __attribute__((ext_vector_type(16))) float fx16; typedef unsigned ux4 __attribute__((ext_vector_type(4)));
    constexpr int UP = POOL_UP;
    const int t0 = R0 % SEQ; const size_t rb = (size_t)(R0 - t0);
    const int lane = tid & 63, r32 = lane & 31, hi = lane >> 5, wid = __builtin_amdgcn_readfirstlane(tid >> 6);
    { ux4 v[9];
#pragma unroll
      for (int k = 0; k < 9; ++k) { const int i = tid + k * NTHR, r = i >> 5, c16 = i & 31, tt = t0 - 8 + r;
          v[k] = (ux4){0u, 0u, 0u, 0u}; if (tt >= 0 && tt < SEQ) v[k] = *(const ux4*)(proj + (rb + tt) * INW + O_P + c16 * 8); }
#pragma unroll
      for (int k = 0; k < 9; ++k) { const int i = tid + k * NTHR, r = i >> 5, c16 = i & 31; *(LAS ux4*)(lds + r * UP + c16 * 16) = v[k]; } }
    __syncthreads();
    const int blk = wid & 3;
#pragma unroll 1
    for (int task = 0; task < 2; ++task) {
        const int g = (wid >> 2) ? (task ? 2 : 1) : (task ? 3 : 0); const int hw = 1 << g;
        const int t = t0 + blk * 32 + r32; int lo = t - hw; if (lo < 0) lo = 0; int hi_ = t + hw; if (hi_ > SEQ) hi_ = SEQ;
        const float inv = 1.f / (float)(hi_ - lo);
        const LAS unsigned char* base = lds + (blk * 32 + r32 + 8) * UP + (g * 64 + hi * 8) * 2;
        bfx8 b0f[4], b1f[4];
#pragma unroll
        for (int ks = 0; ks < 4; ++ks) { b0f[ks] = *(const bfx8*)(wpT + (size_t)(g * 64 + r32) * 64 + ks * 16 + hi * 8); b1f[ks] = *(const bfx8*)(wpT + (size_t)(g * 64 + 32 + r32) * 64 + ks * 16 + hi * 8); }
        bfx8 afr[4];
        if (g == 0) pool_afr<1>(base, inv, afr); else if (g == 1) pool_afr<2>(base, inv, afr); else if (g == 2) pool_afr<4>(base, inv, afr); else pool_afr<8>(base, inv, afr);
        fx16 d0 = fx16{}, d1 = fx16{};
#pragma unroll
        for (int ks = 0; ks < 4; ++ks) {
            d0 = __builtin_amdgcn_mfma_f32_32x32x16_bf16(afr[ks], b0f[ks], d0, 0, 0, 0); d1 = __builtin_amdgcn_mfma_f32_32x32x16_bf16(afr[ks], b1f[ks], d1, 0, 0, 0);
        }
        const float ps0 = pool_scale[g * 64 + r32], ps1 = pool_scale[g * 64 + 32 + r32];
        bf16_t* op = mix + (size_t)(R0 + blk * 32) * D + 512 + g * 64 + r32;
#pragma unroll
        for (int r = 0; r < 16; ++r) { const int orow = (r & 3) + 8 * (r >> 2) + 4 * hi; op[(size_t)orow * D] = f2bf(d0[r] * ps0); op[(size_t)orow * D + 32] = f2bf(d1[r] * ps1); }
    }
    __syncthreads();
#pragma unroll 1
    for (int bt = 0; bt < 2; ++bt) {
        uint4 cb[4], cc[4], cx[4], cm[4], xm[4], cp[4], xp[4];
#pragma unroll
        for (int k = 0; k < 4; ++k) { const int i = tid + (bt * 4 + k) * NTHR, r = i >> 5, j0 = (i & 31) * 8, t = t0 + r; const bf16_t* pr = proj + (size_t)(R0 + r) * INW;
            const bf16_t* pm = t > 0 ? pr - INW : pr; const bf16_t* pp = t < SEQ - 1 ? pr + INW : pr;
            cb[k] = *(const uint4*)(pr + O_B + j0); cc[k] = *(const uint4*)(pr + O_C + j0); cx[k] = *(const uint4*)(pr + O_X + j0);
            cm[k] = *(const uint4*)(pm + O_C + j0); xm[k] = *(const uint4*)(pm + O_X + j0); cp[k] = *(const uint4*)(pp + O_C + j0); xp[k] = *(const uint4*)(pp + O_X + j0); }
#pragma unroll
        for (int k = 0; k < 4; ++k) { const int i = tid + (bt * 4 + k) * NTHR, r = i >> 5, j0 = (i & 31) * 8, t = t0 + r;
            const float mk_m = t > 0 ? 1.f : 0.f, mk_p = t < SEQ - 1 ? 1.f : 0.f;
            const bf16_t* pb = (const bf16_t*)&cb[k]; const bf16_t* pc = (const bf16_t*)&cc[k]; const bf16_t* px = (const bf16_t*)&cx[k];
            const bf16_t* pcm = (const bf16_t*)&cm[k]; const bf16_t* pxm = (const bf16_t*)&xm[k]; const bf16_t* pcp = (const bf16_t*)&cp[k]; const bf16_t* pxp = (const bf16_t*)&xp[k];
            float y[8];
#pragma unroll
            for (int e = 0; e < 8; ++e) { const int j = j0 + e;
                const float u0 = bf2f(pc[e]) * bf2f(px[e]), um = mk_m * (bf2f(pcm[e]) * bf2f(pxm[e])), up = mk_p * (bf2f(pcp[e]) * bf2f(pxp[e]));
                y[e] = bf2f(pb[e]) * (conv_w[j] * um + conv_w[256 + j] * u0 + conv_w[512 + j] * up); }
            uint4 o; o.x = pk2(y[0], y[1]); o.y = pk2(y[2], y[3]); o.z = pk2(y[4], y[5]); o.w = pk2(y[6], y[7]);
            *(uint4*)(mix + (size_t)(R0 + r) * D + 768 + j0) = o; } }
}

#define XB_TMO      128
#define XB_XCNT(j)  (256  + 64 * (j))
#define XB_XSUB(j)  (1280 + 64 * (j))
#define XB_XGEN(j)  (2304 + 64 * (j))
#define XB_TOP      3328
#define XB_TOPGEN   3392
#define XCD_BAR_WORDS 3456
#define XB_SPIN_CAP (1u << 18)

__device__ __forceinline__ unsigned xb_ld(unsigned* p)              { return __hip_atomic_load(p, __ATOMIC_RELAXED, __HIP_MEMORY_SCOPE_AGENT); }
__device__ __forceinline__ unsigned xb_add(unsigned* p, unsigned v) { return __hip_atomic_fetch_add(p, v, __ATOMIC_RELAXED, __HIP_MEMORY_SCOPE_AGENT); }
__device__ __forceinline__ unsigned xb_xcc_id() { return (unsigned)__builtin_amdgcn_s_getreg((3 << 11) | 20) & 0xFu; }
#define XB_SPIN(cond, bar) do { unsigned _sp = 0; while (cond) { __builtin_amdgcn_s_sleep(1); \
    if ((++_sp & 255u) == 0u) { if (xb_ld(&(bar)[XB_TMO])) break; if (_sp > XB_SPIN_CAP) { atomicAdd(&(bar)[XB_TMO], 1u); break; } } } } while (0)

struct XcdBarrier {
    unsigned* bar; unsigned x;
    volatile LAS unsigned* st;
};

__device__ __forceinline__ XcdBarrier xcd_barrier_post(unsigned* bar, volatile LAS unsigned* st) {
    XcdBarrier b; b.bar = bar; b.x = xb_xcc_id(); b.st = st;
    if (threadIdx.x == 0) (void)xb_add(&bar[XB_XCNT(b.x)], 1u);
    return b;
}
__device__ __forceinline__ void xcd_barrier_complete(unsigned* bar, unsigned x, unsigned& nloc, unsigned& nx) {
    const unsigned G = gridDim.x * gridDim.y * gridDim.z;
    unsigned sum, cnt, mine, sp = 0u;
    for (;;) {
        sum = 0u; cnt = 0u; mine = 0u;
#pragma unroll
        for (unsigned j = 0; j < 16; ++j) { const unsigned c = xb_ld(&bar[XB_XCNT(j)]); sum += c; cnt += (c > 0u) ? 1u : 0u; mine = (j == x) ? c : mine; }
        if (sum == G) break;
        __builtin_amdgcn_s_sleep(1);
        if ((++sp & 255u) == 0u) { if (xb_ld(&bar[XB_TMO])) break; if (sp > XB_SPIN_CAP) { atomicAdd(&bar[XB_TMO], 1u); break; } }
    }
    nloc = mine > 0u ? mine : 1u; nx = cnt > 0u ? cnt : 1u;
}

__device__ __forceinline__ void xcd_barrier(const XcdBarrier& b) {
    asm volatile("s_waitcnt vmcnt(0)" ::: "memory");
    __syncthreads();
    if (threadIdx.x == 0) {
        unsigned* bar = b.bar;
        __builtin_amdgcn_s_waitcnt(0);
        unsigned nloc = b.st[0], nx = b.st[1];
        if (nloc == 0u) { xcd_barrier_complete(bar, b.x, nloc, nx); b.st[0] = nloc; b.st[1] = nx; }
        const unsigned old = xb_add(&bar[XB_XSUB(b.x)], 1u);
        const unsigned gen = old / nloc;
        if (old + 1u == (gen + 1u) * nloc) {
            __builtin_amdgcn_fence(__ATOMIC_RELEASE, "agent");
            asm volatile("s_waitcnt vmcnt(0)" ::: "memory");
            const unsigned og = xb_add(&bar[XB_TOP], 1u);
            const unsigned tg = og / nx;
            if (og + 1u == (tg + 1u) * nx) xb_add(&bar[XB_TOPGEN], 1u);
            else XB_SPIN(xb_ld(&bar[XB_TOPGEN]) == tg, bar);
            __builtin_amdgcn_fence(__ATOMIC_ACQUIRE, "agent");
            xb_add(&bar[XB_XGEN(b.x)], 1u);
            asm volatile("s_waitcnt vmcnt(0)" ::: "memory");
        } else {
            XB_SPIN(xb_ld(&bar[XB_XGEN(b.x)]) == gen, bar);
            __builtin_amdgcn_fence(__ATOMIC_ACQUIRE, "agent");
            asm volatile("s_waitcnt vmcnt(0)" ::: "memory");
        }
    }
    __syncthreads();
}
#define XB_XSUB2(j) (12800 - 1024 + 64 * (j))
#define XB_XGEN2(j) (13824 - 1024 + 64 * (j))
#define XB_MISMAP   (14900 - 1024)
__device__ __forceinline__ void xcd_local_barrier(const XcdBarrier& b) {
    asm volatile("s_waitcnt vmcnt(0)" ::: "memory");
    __syncthreads();
    if (threadIdx.x == 0) {
        unsigned* bar = b.bar;
        __builtin_amdgcn_s_waitcnt(0);
        unsigned nloc = b.st[0], nx = b.st[1];
        if (nloc == 0u) { xcd_barrier_complete(bar, b.x, nloc, nx); b.st[0] = nloc; b.st[1] = nx; }
        const unsigned old = xb_add(&bar[XB_XSUB2(b.x)], 1u);
        const unsigned gen = old / nloc;
        if (old + 1u == (gen + 1u) * nloc) xb_add(&bar[XB_XGEN2(b.x)], 1u);
        else XB_SPIN(xb_ld(&bar[XB_XGEN2(b.x)]) == gen, bar);
        __builtin_amdgcn_fence(__ATOMIC_ACQUIRE, "agent");
        asm volatile("s_waitcnt vmcnt(0)" ::: "memory");
    }
    __syncthreads();
}
constexpr int N_PHASES = 16;
#ifndef ATT_SKIP_T
#define ATT_SKIP_T 36
#endif
struct Args { const float* in[19]; float* out; unsigned char* ws; int ph_lo, ph_hi, li, pad; };
__device__ __forceinline__ const float* arg_in(int k) { const int o = launder_s(k * 8); return *(const float* const*)((const char*)__builtin_amdgcn_kernarg_segment_ptr() + o); }
__device__ __forceinline__ unsigned char* arg_ws() { const int o = launder_s(160); return *(unsigned char* const*)((const char*)__builtin_amdgcn_kernarg_segment_ptr() + o); }
__device__ __forceinline__ float* arg_out() { const int o = launder_s(152); return *(float* const*)((const char*)__builtin_amdgcn_kernarg_segment_ptr() + o); }
__global__ void __launch_bounds__(NTHR, 2) mk_fwd(Args a) {
    extern __shared__ __attribute__((aligned(16))) unsigned char lds[];
    cg::grid_group grid = cg::this_grid();
    const int tid = threadIdx.x, wave = __builtin_amdgcn_readfirstlane(tid >> 6);
#define lane (launder_v(tid) & 63)
    const int G = gridDim.x, bx = blockIdx.x; const int vcu = (G % 8 == 0) ? (bx % 8) * (G / 8) + bx / 8 : bx;
    const int gw = vcu * NWAVES + wave, ngw = G * NWAVES;
    __builtin_assume(gw >= 0 && gw < 4096 && ngw > 0);
    LAS unsigned char* ldsl = (LAS unsigned char*)lds;
#define ws (arg_ws())
#define x (arg_in(0))
#define out (arg_out())
#define mod ((float*)(ws + WS_MOD))
#define win_t ((bf16_t*)(ws + WS_WIN))
#define wout_t ((bf16_t*)(ws + WS_WOUT))
#define wgu_t ((bf16_t*)(ws + WS_WGU))
#define wdn_t ((bf16_t*)(ws + WS_WDN))
#define xb ((bf16_t*)(ws + WS_XB))
#define hb ((bf16_t*)(ws + WS_H))
#define mix ((bf16_t*)(ws + WS_MIX))
#define proj ((bf16_t*)(ws + WS_PROJ))
#define act ((bf16_t*)(ws + WS_ACT))
    const int lo = a.ph_lo, hi = a.ph_hi;
    const bool fuse = G == 256 && lo == 0 && hi == N_PHASES;
#define NORM_PART(k) ((float*)(ws + WS_PART) + (size_t)(k) * 131072)
#define NORM_CNT(k) ((unsigned*)(ws + WS_CTL) + 4608 + (k) * 2048)
#define NORM_LS ((LAS float*)(ldsl + MISC_OFF + 1024))
    for (int u = tid; u < (LDS_BYTES - MISC_OFF) / 4; u += NTHR) ((LAS unsigned*)(ldsl + MISC_OFF))[u] = 0u;
    __syncthreads();
    XcdBarrier bar = xcd_barrier_post((unsigned*)(ws + WS_CTL) + 1024 + a.li * XCD_BAR_WORDS, (volatile LAS unsigned*)(ldsl + MISC_OFF) + 8);
    if (tid == 0) (void)__hip_atomic_fetch_or(bar.bar + XB_MISMAP + (bx & 7), 1u << xb_xcc_id(), __ATOMIC_RELAXED, __HIP_MEMORY_SCOPE_AGENT);
#define IN(k) (lo <= (k) && (k) < hi)
#define INL(j) (lo <= (pb + (j)) && (pb + (j)) < hi)
#define SEAML(j) do { if (lo <= (pb + (j)) && (pb + (j)) + 1 < hi) { if (localok) xcd_local_barrier(bar); else xcd_barrier(bar); } } while (0)
#define SEAM(k) do { if (lo <= (k) && (k) + 1 < hi) grid.sync(); } while (0)

    if (IN(0)) {
        LAS float* scr = (LAS float*)(ldsl + wave * 16640);
        int cursor = 0;
        for (int l = 0; l < DEPTH; ++l) {
            p0_transpose_matrix(arg_in(5) + (size_t)l * D * INW, D, INW, win_t + (size_t)l * INW * D, false, scr, gw, ngw, lane, cursor);
            p0_transpose_matrix(arg_in(14) + (size_t)l * D * D, D, D, wout_t + (size_t)l * D * D, false, scr, gw, ngw, lane, cursor);
            p0_transpose_matrix(arg_in(16) + (size_t)l * D * NGU, D, NGU, wgu_t + (size_t)l * NGU * D, true, scr, gw, ngw, lane, cursor);
            p0_transpose_matrix(arg_in(17) + (size_t)l * DFF * D, DFF, D, wdn_t + (size_t)l * D * DFF, false, scr, gw, ngw, lane, cursor);
        }
        { bf16_t* wpT = (bf16_t*)(ws + WS_WPT);
          for (int i = gw * 64 + lane; i < DEPTH * 4 * 4096; i += ngw * 64) { const int lg = i >> 12, d = (i >> 6) & 63, c = i & 63; wpT[i] = f2bf(arg_in(11)[(size_t)lg * 4096 + c * 64 + d]); } }
        __syncthreads();
        for (int u = bx; u < 192; u += G) p0_mod_unit(arg_in(1), arg_in(2), arg_in(3), mod, u, (LAS float*)ldsl, tid);
    }
    SEAM(0);
    bool localok = fuse;
    for (int g8 = 0; g8 < 8; ++g8) { const unsigned mk = (unsigned)__builtin_amdgcn_readfirstlane((int)xb_ld((unsigned*)(ws + WS_CTL) + 1024 + XB_MISMAP + g8)); localok = localok && mk != 0u && (mk & (mk - 1u)) == 0u; }

    for (int l = 0; l < DEPTH; ++l) {
        const int pb = launder_s(1 + 7 * l);
        const float* modl = mod + (size_t)l * 8 * 6144;
        if (INL(0) && !(fuse && l > 0)) {
            const int m_lo = fuse ? (bx & 7) * SEQ + ((bx >> 3) * NWAVES + wave) * 16 : gw * 4, m_hi = fuse ? m_lo + 16 : M, m_st = fuse ? 4 : ngw * 4;
            for (int m = m_lo; m < m_hi; m += m_st) { const float* mb = modl + (size_t)(m / SEQ) * 6144;
                if (l == 0) norm_rows<true, true, 4>(x + (size_t)m * D, arg_in(4) + l * D, mb + 0, mb + 1024, hb + (size_t)m * D, nullptr, lane);
                else norm_rows<false, true, 4>(xb + (size_t)m * D, arg_in(4) + l * D, mb + 0, mb + 1024, hb + (size_t)m * D, nullptr, lane); }
        }
        if (!(fuse && l > 0)) SEAML(0);
        if (INL(1)) {
            pg8::Gemm g{hb, win_t + (size_t)l * INW * D, M, INW, D}; pg8::StaticOrder S; S.init(M, INW, G, bx);
            pg8::EpiProj E{proj, INW, C2, (unsigned*)(ws + WS_KN2) + l * 8192, BPAD};
            pg8::gemm_phase<pg8::EpiProj, pg8::StaticOrder, true, true>(ldsl, g, S, E);
        }
        SEAML(1);
        if (INL(2)) {
            const float lambda_init = l == 0 ? 0.2f : 0.35550906759096926f;
            float d1 = 0.f, d2 = 0.f;
            for (int i = 0; i < 32; ++i) { d1 += arg_in(6)[l * 32 + i] * arg_in(7)[l * 32 + i]; d2 += arg_in(8)[l * 32 + i] * arg_in(9)[l * 32 + i]; }
            const float lam = __expf(d1) - __expf(d2) + lambda_init;
            const unsigned* kn2 = (const unsigned*)(ws + WS_KN2) + l * 8192;
            {
                const bool useq = G == 256; const int xg = bx & 7;
                unsigned* qcnt = (unsigned*)(ws + WS_CTL) + 15000 + (l * 8 + xg) * 64;
                volatile LAS unsigned* qw = (volatile LAS unsigned*)(ldsl + MISC_OFF) + 16;
                if (useq) { if (tid == 0) qw[0] = __hip_atomic_fetch_add(qcnt, 1u, __ATOMIC_RELAXED, __HIP_MEMORY_SCOPE_AGENT); __syncthreads(); }
                int sidx = bx;
                for (int it = 0;; ++it) {
                    int idx, bsel; unsigned nxt = 0u;
                    if (useq) { idx = (int)qw[it & 1]; if (idx >= 160) break; bsel = xg; if (tid == 0) nxt = __hip_atomic_fetch_add(qcnt, 1u, __ATOMIC_RELAXED, __HIP_MEMORY_SCOPE_AGENT); }
                    else { if (sidx >= BATCH * 160) break; bsel = sidx / 160; idx = sidx % 160; sidx += G; }
                    const int cls = idx >> 4, e = idx & 15;
                    if (cls >= 8) {
                        const int r = bsel * 32 + (idx - 128);
                        poolconv_rows(proj + (size_t)bsel * BPAD, mix, (const bf16_t*)(ws + WS_WPT) + (size_t)l * 4 * 4096, arg_in(12) + l * 256, arg_in(13) + l * 768, r * 128, ldsl, launder_v(tid));
                    } else {
                        const int hsel = 7 - cls;
                        const int qb = (e & 1) ? 8 + (e >> 1) : 7 - (e >> 1);
                        att::attn_unit<20, ATT_SKIP_T>(bsel, hsel, qb, proj + (size_t)bsel * BPAD, mix, arg_in(10) + l * 512 + hsel * 64, lam, 1.f - lambda_init, kn2, (char*)lds);
                    }
                    if (useq && tid == 0) qw[(it + 1) & 1] = nxt;
                    __syncthreads();
                }
            }
        }
        SEAML(2);
        if (INL(3)) {
            pg8::Gemm g{mix, wout_t + (size_t)l * D * D, M, D, D}; pg8::StaticOrder S; S.init(M, D, G, bx);
            if (fuse) {
                if (l == 0) { pg8::EpiResidNorm<true, false> E{x, xb, D, modl + 2048, SEQ, arg_in(15) + l * D, modl + 3072, modl + 4096, hb, nullptr, NORM_PART(2 * l), NORM_CNT(2 * l), NORM_LS}; pg8::gemm_phase<pg8::EpiResidNorm<true, false>, pg8::StaticOrder, true, true>(ldsl, g, S, E); }
                else { pg8::EpiResidNorm<false, false> E{xb, xb, D, modl + 2048, SEQ, arg_in(15) + l * D, modl + 3072, modl + 4096, hb, nullptr, NORM_PART(2 * l), NORM_CNT(2 * l), NORM_LS}; pg8::gemm_phase<pg8::EpiResidNorm<false, false>, pg8::StaticOrder, true, true>(ldsl, g, S, E); }
            } else {
            if (l == 0) { pg8::EpiResid<true> E{x, xb, D, modl + 2048, SEQ}; pg8::gemm_phase<pg8::EpiResid<true>, pg8::StaticOrder, true, true>(ldsl, g, S, E); }
            else { pg8::EpiResid<false> E{xb, xb, D, modl + 2048, SEQ}; pg8::gemm_phase<pg8::EpiResid<false>, pg8::StaticOrder, true, true>(ldsl, g, S, E); }
            }
        }
        if (!fuse) SEAML(3);
        if (INL(4) && !fuse) {
            for (int m = gw * 4; m < M; m += ngw * 4) { const float* mb = modl + (size_t)(m / SEQ) * 6144;
                norm_rows<false, true, 4>(xb + (size_t)m * D, arg_in(15) + l * D, mb + 3072, mb + 4096, hb + (size_t)m * D, nullptr, lane); }
        }
        SEAML(4);
        if (INL(5)) {
            pg8::Gemm g{hb, wgu_t + (size_t)l * NGU * D, M, NGU, D}; pg8::StaticOrder S; S.init(M, NGU, G, bx);
            pg8::EpiSwiglu E{act, DFF};
            pg8::gemm_phase<pg8::EpiSwiglu, pg8::StaticOrder, true, true>(ldsl, g, S, E);
        }
        SEAML(5);
        if (INL(6)) {
            pg8::Gemm g{act, wdn_t + (size_t)l * D * DFF, M, D, DFF}; pg8::StaticOrder S; S.init(M, D, G, bx);
            if (fuse) {
                if (l + 1 < DEPTH) { const float* modn = mod + (size_t)(l + 1) * 8 * 6144;
                    pg8::EpiResidNorm<false, false> E{xb, xb, D, modl + 5120, SEQ, arg_in(4) + (l + 1) * D, modn + 0, modn + 1024, hb, nullptr, NORM_PART(2 * l + 1), NORM_CNT(2 * l + 1), NORM_LS}; pg8::gemm_phase<pg8::EpiResidNorm<false, false>, pg8::StaticOrder, true, true>(ldsl, g, S, E); }
                else { pg8::EpiResidNorm<false, true> E{xb, xb, D, modl + 5120, SEQ, arg_in(18), nullptr, nullptr, nullptr, out, NORM_PART(2 * l + 1), NORM_CNT(2 * l + 1), NORM_LS}; pg8::gemm_phase<pg8::EpiResidNorm<false, true>, pg8::StaticOrder, true, true>(ldsl, g, S, E); }
            } else {
            pg8::EpiResid<false> E{xb, xb, D, modl + 5120, SEQ};
            pg8::gemm_phase<pg8::EpiResid<false>, pg8::StaticOrder, true, true>(ldsl, g, S, E);
            }
        }
        if (!(fuse && l + 1 == DEPTH)) SEAML(6);
    }
    if (IN(15) && !fuse) {
        for (int m = gw * 4; m < M; m += ngw * 4) norm_rows<false, false, 4>(xb + (size_t)m * D, arg_in(18), nullptr, nullptr, nullptr, out + (size_t)m * D, lane);
    }
#undef lane
#undef ws
#undef x
#undef out
#undef mod
#undef win_t
#undef wout_t
#undef wgu_t
#undef wdn_t
#undef xb
#undef hb
#undef mix
#undef proj
#undef act
#undef IN
#undef INL
#undef SEAM
#undef SEAML
#undef NORM_PART
#undef NORM_CNT
#undef NORM_LS
}

extern "C" void kernel_launch(void* const* d_in, const int* in_sizes, int n_in, void* d_out, int out_size, void* d_ws, size_t ws_size, hipStream_t stream) {
    static int grid = 0;
    if (grid == 0) {
        if (n_in != 19 || in_sizes[0] != M * D || out_size != M * D || ws_size < WS_END) { fprintf(stderr, "kernel_launch: unexpected shapes / workspace (n_in %d, ws %zu); nothing launched\n", n_in, ws_size); grid = -1; return; }
        int dev = 0, cus = 0, per_cu = 0;
        if (hipGetDevice(&dev) != hipSuccess || hipDeviceGetAttribute(&cus, hipDeviceAttributeMultiprocessorCount, dev) != hipSuccess) { grid = -1; return; }
        if (hipFuncSetAttribute((const void*)mk_fwd, hipFuncAttributeMaxDynamicSharedMemorySize, LDS_BYTES) != hipSuccess) { fprintf(stderr, "kernel_launch: hipFuncSetAttribute failed\n"); grid = -1; return; }
        if (hipOccupancyMaxActiveBlocksPerMultiprocessor(&per_cu, (const void*)mk_fwd, NTHR, LDS_BYTES) != hipSuccess || per_cu < 1) { fprintf(stderr, "kernel_launch: occupancy query says %d blocks per CU\n", per_cu); (void)hipGetLastError(); grid = -1; return; }
        grid = cus;
    }
    if (grid < 0) return;
    (void)hipMemsetAsync((char*)d_ws + WS_CTL, 0, CTL_ZERO_BYTES, stream);
    Args a{};
    for (int i = 0; i < 19; ++i) a.in[i] = (const float*)d_in[i];
    a.out = (float*)d_out; a.ws = (unsigned char*)d_ws;
    a.ph_lo = 0; a.ph_hi = N_PHASES; a.li = 0;
    void* args[] = {&a};
    const hipError_t le = hipLaunchCooperativeKernel((const void*)mk_fwd, dim3(grid), dim3(NTHR), args, LDS_BYTES, stream);
    if (le != hipSuccess) fprintf(stderr, "kernel_launch: cooperative launch failed: %s (grid %d)\n", hipGetErrorString(le), grid);
}
```

```cpp
#include <hip/hip_runtime.h>
#include <hip/hip_cooperative_groups.h>
#include <cstdio>
#include <cstdint>
namespace cg = cooperative_groups;

typedef unsigned short bf16_t;
constexpr int BATCH = 8, SEQ = 4096, D = 1024, M = BATCH * SEQ, DEPTH = 2;
constexpr int INW = 2560, DFF = 2816, NGU = 2 * DFF;
constexpr int O_Q = 0, O_K = 512, O_V = 1024, O_P = 1536, O_B = 1792, O_C = 2048, O_X = 2304;
constexpr float EPS = 1e-6f;
constexpr float LOG2E = 1.4426950408889634f;
constexpr float C2 = 0.17677669529663687f * 1.4426950408889634f;

__device__ __forceinline__ float bf2f(bf16_t v) { return __uint_as_float(((unsigned)v) << 16); }
__device__ __forceinline__ bf16_t f2bf(float f) { unsigned u = __float_as_uint(f); return (bf16_t)((u + 0x7fffu + ((u >> 16) & 1u)) >> 16); }
__device__ __forceinline__ unsigned pk2(float lo, float hi) { return (unsigned)f2bf(lo) | ((unsigned)f2bf(hi) << 16); }

constexpr size_t MiB = 1u << 20;
constexpr size_t WS_CTL = 0, CTL_ZERO_BYTES = 128 * 1024;
constexpr size_t WS_KN2 = 64 * 1024;
constexpr size_t WS_MOD = 1 * MiB;
constexpr size_t WS_WIN = 2 * MiB;
constexpr size_t WS_WOUT = 12 * MiB;
constexpr size_t WS_WGU = 16 * MiB;
constexpr size_t WS_WDN = 38 * MiB;
constexpr size_t WS_WPT = 49 * MiB;
constexpr size_t WS_H = 50 * MiB;
constexpr size_t WS_MIX = 114 * MiB;
constexpr size_t BPAD = (size_t)SEQ * (DFF - INW);
constexpr size_t WS_PROJ = 178 * MiB;
constexpr size_t WS_ACT = 178 * MiB;
constexpr size_t WS_XB = 354 * MiB;
constexpr size_t WS_PART = 418 * MiB;
constexpr size_t WS_END = 420 * MiB;

__device__ __forceinline__ int launder_v(int v) { asm volatile("" : "+v"(v)); return v; }
__device__ __forceinline__ int launder_s(int v) { asm volatile("" : "+s"(v)); return v; }
#define GAS __attribute__((address_space(1)))
#define LAS __attribute__((address_space(3)))
typedef GAS unsigned gu32;
#define RLX_AGENT __ATOMIC_RELAXED, __HIP_MEMORY_SCOPE_AGENT
#define LDS_WAIT() asm volatile("s_waitcnt lgkmcnt(0)" ::: "memory")
#define VM_WAIT() asm volatile("s_waitcnt vmcnt(0)" ::: "memory")

namespace pg8 {
#define PG8_LAS __attribute__((address_space(3)))
typedef unsigned short bf16_t;
typedef short bf16x8 __attribute__((ext_vector_type(8)));
typedef float f32x4 __attribute__((ext_vector_type(4)));
typedef unsigned u32x4 __attribute__((ext_vector_type(4)));
constexpr int BM = 256, BK = 64, HALF = 128, HTB = HALF * BK * 2  , STAGE_BYTES = 8 * HTB, NXCD = 8, WGM = 4;

__host__ __device__ __forceinline__ int lds_byte(int r, int c) { const int st = (r >> 4) * 2 + (c >> 5), rr = r & 15, cc = c & 31, ob = rr * 64 + cc * 2; return st * 1024 + (ob ^ (((ob >> 9) & 1) << 5)); }
__host__ __device__ __forceinline__ void stage_rc(int b, int& R, int& C) { const int st = b / 1024, sb = b % 1024, swz = sb ^ (((sb >> 9) & 1) << 5); R = (st >> 1) * 16 + swz / 64; C = (st & 1) * 32 + (swz % 64) / 2; }
__host__ __device__ __forceinline__ int perm32(int rho) { const int n = rho >> 4, i = rho & 15; return 8 * (i >> 2) + 4 * n + (i & 3); }

struct Unit { int pm, pn; };
struct Gemm { const bf16_t* A; const bf16_t* Bt; int M, N, K; };

struct StaticOrder {
    int nM, nN, nwg, G, c;
    __host__ __device__ void init(int M, int N, int G_, int c_) { nM = M / BM; nN = N / BM; nwg = nM * nN; G = G_; c = c_; }
    __host__ __device__ bool next(int i, Unit& u) const {
        const long L = (long)i * G + c; if (L >= nwg) return false;
        int wgid = (int)L; { const int q = nwg / NXCD, r = nwg % NXCD, xcd = wgid % NXCD, off = wgid / NXCD; wgid = (xcd < r ? xcd * (q + 1) : r * (q + 1) + (xcd - r) * q) + off; }
        const int nig = WGM * nN, gid = wgid / nig, fm = gid * WGM, gsz = (nM - fm) < WGM ? (nM - fm) : WGM;
        u.pm = fm + ((wgid % nig) % gsz); u.pn = (wgid % nig) / gsz; return true;
    }
    __device__ __forceinline__ void a_ready(const Unit&) const {}
    __device__ __forceinline__ void done(const Unit&) const {}
};

__device__ __forceinline__ unsigned cvt_pk_bf16(float lo, float hi) { unsigned r; asm volatile("v_cvt_pk_bf16_f32 %0, %1, %2" : "=v"(r) : "v"(lo), "v"(hi)); return r; }
typedef float f32x2 __attribute__((ext_vector_type(2)));
struct EpiProj {
    static constexpr bool PERM = true, AFTER_DRAIN = false;
    bf16_t* O; int ldc; float qscale; unsigned* kn2; size_t bpad;
    __device__ __forceinline__ void operator()(const f32x4 (&acc)[2][2][4][2], const Unit& u, int wr, int wc, int fr, int fq) const {
        const int row0 = u.pm * BM + wr * 64 + fr, col0 = u.pn * BM + wc * 32 + 8 * fq;
        const float sc = u.pn < 2 ? qscale : 1.f;
#pragma unroll
        for (int ai = 0; ai < 2; ++ai)
#pragma unroll
            for (int m = 0; m < 4; ++m) { bf16_t* rowp = O + (size_t)(u.pm >> 4) * bpad + (size_t)(row0 + ai * HALF + m * 16) * ldc + col0;
#pragma unroll
                for (int bj = 0; bj < 2; ++bj) { const f32x4 v0 = acc[ai][bj][m][0] * sc, v1 = acc[ai][bj][m][1] * sc;
                    u32x4 w; w.x = cvt_pk_bf16(v0[0], v0[1]); w.y = cvt_pk_bf16(v0[2], v0[3]); w.z = cvt_pk_bf16(v1[0], v1[1]); w.w = cvt_pk_bf16(v1[2], v1[3]);
                    *(u32x4*)(rowp + bj * HALF) = w; } }
        if (u.pn == 2 || u.pn == 3) {
#pragma unroll
            for (int ai = 0; ai < 2; ++ai)
#pragma unroll
                for (int bj = 0; bj < 2; ++bj) { float mx = 0.f;
#pragma unroll
                    for (int m = 0; m < 4; ++m) { const f32x4 a = acc[ai][bj][m][0], b = acc[ai][bj][m][1];
                        float ss = (a[0] * a[0] + a[1] * a[1]) + (a[2] * a[2] + a[3] * a[3]) + (b[0] * b[0] + b[1] * b[1]) + (b[2] * b[2] + b[3] * b[3]);
                        ss += __shfl_xor(ss, 16); ss += __shfl_xor(ss, 32); mx = fmaxf(mx, ss); }
                    mx = fmaxf(mx, __shfl_xor(mx, 1)); mx = fmaxf(mx, __shfl_xor(mx, 2)); mx = fmaxf(mx, __shfl_xor(mx, 4)); mx = fmaxf(mx, __shfl_xor(mx, 8));
                    if (fr == 0 && fq == 0) { const int b = u.pm >> 4, tile = (u.pm * 4 + ai * 2 + wr) & 63, head = (u.pn - 2) * 4 + bj * 2 + (wc >> 1), half = wc & 1;
                        atomicMax(kn2 + ((b * 8 + head) * 2 + half) * 64 + tile, __float_as_uint(mx)); } }
        }
    }
};
__device__ __forceinline__ float silu_mul(float g, float u) { return g * u * __builtin_amdgcn_rcpf(1.f + __builtin_amdgcn_exp2f(-1.4426950408889634f * g)); }
struct EpiSwiglu {
    static constexpr bool PERM = true, AFTER_DRAIN = false;
    bf16_t* O; int ldc;
    __device__ __forceinline__ void operator()(const f32x4 (&acc)[2][2][4][2], const Unit& u, int wr, int wc, int fr, int fq) const {
        const int row0 = u.pm * BM + wr * 64 + fr, col0 = u.pn * HALF + wc * 32 + 8 * fq;
#pragma unroll
        for (int ai = 0; ai < 2; ++ai)
#pragma unroll
            for (int m = 0; m < 4; ++m) { bf16_t* rowp = O + (size_t)(row0 + ai * HALF + m * 16) * ldc + col0;
                const f32x4 g0 = acc[ai][0][m][0], g1 = acc[ai][0][m][1], u0 = acc[ai][1][m][0], u1 = acc[ai][1][m][1];
                u32x4 w; w.x = cvt_pk_bf16(silu_mul(g0[0], u0[0]), silu_mul(g0[1], u0[1])); w.y = cvt_pk_bf16(silu_mul(g0[2], u0[2]), silu_mul(g0[3], u0[3]));
                w.z = cvt_pk_bf16(silu_mul(g1[0], u1[0]), silu_mul(g1[1], u1[1])); w.w = cvt_pk_bf16(silu_mul(g1[2], u1[2]), silu_mul(g1[3], u1[3]));
                *(u32x4*)rowp = w; }
    }
};
template <bool BASE_F32>
struct EpiResid {
    static constexpr bool PERM = true, AFTER_DRAIN = false;
    const void* base; bf16_t* out; int ldc; const float* gt; int rows_per_batch;
    __device__ __forceinline__ void operator()(const f32x4 (&acc)[2][2][4][2], const Unit& u, int wr, int wc, int fr, int fq) const {
        const int col0 = u.pn * BM + wc * 32 + 8 * fq; const int b = (u.pm * BM) / rows_per_batch;
        f32x4 gv[2][2];
#pragma unroll
        for (int bj = 0; bj < 2; ++bj)
#pragma unroll
            for (int n = 0; n < 2; ++n) gv[bj][n] = *(const f32x4*)(gt + (size_t)b * 6144 + col0 + bj * HALF + 4 * n);
#pragma unroll
        for (int ai = 0; ai < 2; ++ai) {
            u32x4 wb[4][2]; f32x4 wf[BASE_F32 ? 4 : 1][2][2];
#pragma unroll
            for (int m = 0; m < 4; ++m) { const size_t off = (size_t)(u.pm * BM + ai * HALF + wr * 64 + m * 16 + fr) * ldc + col0;
#pragma unroll
                for (int bj = 0; bj < 2; ++bj) {
                    if (BASE_F32) { wf[m][bj][0] = *(const f32x4*)((const float*)base + off + bj * HALF); wf[m][bj][1] = *(const f32x4*)((const float*)base + off + bj * HALF + 4); }
                    else wb[m][bj] = *(const u32x4*)((const bf16_t*)base + off + bj * HALF); } }
#pragma unroll
            for (int m = 0; m < 4; ++m) { const size_t off = (size_t)(u.pm * BM + ai * HALF + wr * 64 + m * 16 + fr) * ldc + col0;
#pragma unroll
                for (int bj = 0; bj < 2; ++bj) { f32x4 b0, b1;
                    if (BASE_F32) { b0 = wf[m][bj][0]; b1 = wf[m][bj][1]; }
                    else { const u32x4 w = wb[m][bj];
                        b0 = (f32x4){__uint_as_float(w.x << 16), __uint_as_float(w.x & 0xffff0000u), __uint_as_float(w.y << 16), __uint_as_float(w.y & 0xffff0000u)};
                        b1 = (f32x4){__uint_as_float(w.z << 16), __uint_as_float(w.z & 0xffff0000u), __uint_as_float(w.w << 16), __uint_as_float(w.w & 0xffff0000u)}; }
                    const f32x4 x0 = b0 + gv[bj][0] * acc[ai][bj][m][0], x1 = b1 + gv[bj][1] * acc[ai][bj][m][1];
                    u32x4 o; o.x = cvt_pk_bf16(x0[0], x0[1]); o.y = cvt_pk_bf16(x0[2], x0[3]); o.z = cvt_pk_bf16(x1[0], x1[1]); o.w = cvt_pk_bf16(x1[2], x1[3]);
                    *(u32x4*)(out + off + bj * HALF) = o; } }
        }
    }
};
template <bool BASE_F32, bool FINAL>
struct EpiResidNorm {
    static constexpr bool PERM = true, AFTER_DRAIN = false;
    const void* base; bf16_t* xout; int ldc; const float* gt; int rows_per_batch;
    const float* g; const float* sh; const float* sc; bf16_t* h; float* fout;
    float* part; unsigned* cnt; PG8_LAS float* ls;
    __device__ __forceinline__ void operator()(const f32x4 (&acc)[2][2][4][2], const Unit& u, int wr, int wc, int fr, int fq) const {
#define PG8_LBAR() asm volatile("s_waitcnt lgkmcnt(0)\n\ts_barrier" ::: "memory")
        const int tid = launder_v((int)threadIdx.x);
        const int col0 = u.pn * BM + wc * 32 + 8 * fq; const int b = (u.pm * BM) / rows_per_batch;
        const int lrow = launder_v(wr * 64 + fr);
        f32x4 xv[2][2][4][2]; float ss[2][4];
        { f32x4 gv[2][2];
#pragma unroll
          for (int bj = 0; bj < 2; ++bj)
#pragma unroll
            for (int n = 0; n < 2; ++n) gv[bj][n] = *(const f32x4*)(gt + (size_t)b * 6144 + col0 + bj * HALF + 4 * n);
#pragma unroll
          for (int ai = 0; ai < 2; ++ai) {
            constexpr int MB = BASE_F32 ? 2 : 4;
#pragma unroll
            for (int m0 = 0; m0 < 4; m0 += MB) {
            u32x4 wb[MB][2]; f32x4 wf[MB][2][2];
#pragma unroll
            for (int mm = 0; mm < MB; ++mm) { const int m = m0 + mm; const size_t off = (size_t)(u.pm * BM + ai * HALF + wr * 64 + m * 16 + fr) * ldc + col0;
#pragma unroll
                for (int bj = 0; bj < 2; ++bj) {
                    if (BASE_F32) { wf[mm][bj][0] = *(const f32x4*)((const float*)base + off + bj * HALF); wf[mm][bj][1] = *(const f32x4*)((const float*)base + off + bj * HALF + 4); }
                    else wb[mm][bj] = *(const u32x4*)((const bf16_t*)base + off + bj * HALF); } }
#pragma unroll
            for (int mm = 0; mm < MB; ++mm) { const int m = m0 + mm; float s = 0.f;
#pragma unroll
                for (int bj = 0; bj < 2; ++bj) { f32x4 b0, b1;
                    if (BASE_F32) { b0 = wf[mm][bj][0]; b1 = wf[mm][bj][1]; }
                    else { const u32x4 w = wb[mm][bj];
                        b0 = (f32x4){__uint_as_float(w.x << 16), __uint_as_float(w.x & 0xffff0000u), __uint_as_float(w.y << 16), __uint_as_float(w.y & 0xffff0000u)};
                        b1 = (f32x4){__uint_as_float(w.z << 16), __uint_as_float(w.z & 0xffff0000u), __uint_as_float(w.w << 16), __uint_as_float(w.w & 0xffff0000u)}; }
                    const f32x4 x0 = b0 + gv[bj][0] * acc[ai][bj][m][0], x1 = b1 + gv[bj][1] * acc[ai][bj][m][1];
                    xv[ai][bj][m][0] = x0; xv[ai][bj][m][1] = x1;
                    s += (x0[0] * x0[0] + x0[1] * x0[1]) + (x0[2] * x0[2] + x0[3] * x0[3]) + (x1[0] * x1[0] + x1[1] * x1[1]) + (x1[2] * x1[2] + x1[3] * x1[3]); }
                s += __shfl_xor(s, 16); s += __shfl_xor(s, 32); ss[ai][m] = s; } } } }
        const int wid = tid >> 6, ln = tid & 63;
        if (fq == 0) {
#pragma unroll
            for (int ai = 0; ai < 2; ++ai)
#pragma unroll
                for (int m = 0; m < 4; ++m) ls[(ai * HALF + m * 16 + lrow) * 4 + wc] = ss[ai][m]; }
        PG8_LBAR();
        const int row = wid * 32 + (ln & 31);
        if (ln < 32) { const f32x4 p4 = *(const PG8_LAS f32x4*)(ls + row * 4);
            __hip_atomic_store(part + ((size_t)u.pm * 256 + row) * 4 + u.pn, (p4[0] + p4[1]) + (p4[2] + p4[3]), __ATOMIC_RELAXED, __HIP_MEMORY_SCOPE_AGENT); }
        asm volatile("s_waitcnt vmcnt(0)" ::: "memory");
        if (ln == 0) __hip_atomic_fetch_add(cnt + 16 * u.pm, 1u, __ATOMIC_RELAXED, __HIP_MEMORY_SCOPE_AGENT);
        if (!FINAL) {
#pragma unroll
            for (int bj = 0; bj < 2; ++bj)
#pragma unroll
                for (int ai = 0; ai < 2; ++ai)
#pragma unroll
                    for (int m = 0; m < 4; ++m) { const size_t off = (size_t)(u.pm * BM + ai * HALF + wr * 64 + m * 16 + fr) * ldc + col0 + bj * HALF;
                        const f32x4 x0 = xv[ai][bj][m][0], x1 = xv[ai][bj][m][1];
                        u32x4 o; o.x = cvt_pk_bf16(x0[0], x0[1]); o.y = cvt_pk_bf16(x0[2], x0[3]); o.z = cvt_pk_bf16(x1[0], x1[1]); o.w = cvt_pk_bf16(x1[2], x1[3]);
                        *(u32x4*)(xout + off) = o; } }
        if (wid == 0) {
            while ((unsigned)__builtin_amdgcn_readfirstlane(__hip_atomic_load(cnt + 16 * u.pm, __ATOMIC_RELAXED, __HIP_MEMORY_SCOPE_AGENT)) < 32u) __builtin_amdgcn_s_sleep(8);
            __builtin_amdgcn_fence(__ATOMIC_ACQUIRE, "agent");
            asm volatile("s_waitcnt vmcnt(0)" ::: "memory"); }
        asm volatile("s_waitcnt lgkmcnt(0)\n\ts_barrier" ::: "memory");
        if (ln < 32) { const float* pp = part + ((size_t)u.pm * 256 + row) * 4;
            const float s = (__hip_atomic_load(pp, __ATOMIC_RELAXED, __HIP_MEMORY_SCOPE_AGENT) + __hip_atomic_load(pp + 1, __ATOMIC_RELAXED, __HIP_MEMORY_SCOPE_AGENT))
                          + (__hip_atomic_load(pp + 2, __ATOMIC_RELAXED, __HIP_MEMORY_SCOPE_AGENT) + __hip_atomic_load(pp + 3, __ATOMIC_RELAXED, __HIP_MEMORY_SCOPE_AGENT));
            ls[1024 + row] = rsqrtf(s * (1.f / 1024.f) + EPS); }
        PG8_LBAR();
        float rs[2][4];
#pragma unroll
        for (int ai = 0; ai < 2; ++ai)
#pragma unroll
            for (int m = 0; m < 4; ++m) rs[ai][m] = ls[1024 + ai * HALF + m * 16 + lrow];
#pragma unroll
        for (int bj = 0; bj < 2; ++bj) {
            const int c = col0 + bj * HALF;
            f32x4 gm0 = *(const f32x4*)(g + c), gm1 = *(const f32x4*)(g + c + 4), sh0 = (f32x4){0.f, 0.f, 0.f, 0.f}, sh1 = sh0;
            if (!FINAL) { const f32x4 s0 = *(const f32x4*)(sc + (size_t)b * 6144 + c), s1 = *(const f32x4*)(sc + (size_t)b * 6144 + c + 4);
                gm0 = gm0 * (1.f + s0); gm1 = gm1 * (1.f + s1); sh0 = *(const f32x4*)(sh + (size_t)b * 6144 + c); sh1 = *(const f32x4*)(sh + (size_t)b * 6144 + c + 4); }
#pragma unroll
            for (int ai = 0; ai < 2; ++ai)
#pragma unroll
                for (int m = 0; m < 4; ++m) { const size_t off = (size_t)(u.pm * BM + ai * HALF + wr * 64 + m * 16 + fr) * ldc + c;
                    const f32x4 x0 = xv[ai][bj][m][0], x1 = xv[ai][bj][m][1]; const float r = rs[ai][m];
                    if (FINAL) { *(f32x4*)(fout + off) = x0 * r * gm0; *(f32x4*)(fout + off + 4) = x1 * r * gm1; }
                    else { const f32x4 h0 = x0 * r * gm0 + sh0, h1 = x1 * r * gm1 + sh1;
                        u32x4 q; q.x = cvt_pk_bf16(h0[0], h0[1]); q.y = cvt_pk_bf16(h0[2], h0[3]); q.z = cvt_pk_bf16(h1[0], h1[1]); q.w = cvt_pk_bf16(h1[2], h1[3]);
                        *(u32x4*)(h + off) = q; } } }
#undef PG8_LBAR
    }
};

template <class Epi, class Sched, bool ALIGN_EPI = false, bool SP2 = false>
__device__ __forceinline__ void gemm_phase(PG8_LAS unsigned char* lds, const Gemm g, const Sched& S, const Epi& E) {
    const int tid = launder_v((int)threadIdx.x), wid = __builtin_amdgcn_readfirstlane(tid >> 6), lane = tid & 63, wr = wid >> 2, wc = wid & 3, fr = lane & 15, fq = lane >> 4;
    const int K = g.K, nt = K / BK;
    unsigned voffA[2], voffB[2];
#pragma unroll
    for (int i = 0; i < 2; ++i) { int R, C; stage_rc(tid * 16 + i * 8192, R, C); const int Rb = Epi::PERM ? ((R & ~31) + perm32(R & 31)) : R;
        voffA[i] = (unsigned)(R * K + C) * 2u; voffB[i] = (unsigned)(Rb * K + C) * 2u; }
    const size_t kstep = (size_t)(BK * 2);
    const size_t hstep = (size_t)HALF * K * 2;
    const size_t tstep = 2 * hstep;
    const unsigned ldsw = (unsigned)wid * 1024u;
    const int aoff = lds_byte(wr * 64 + fr, fq * 8), boff = lds_byte(wc * 32 + fr, fq * 8);
#define PG8_SA(b, h) (((b) * 2 + (h)) * HTB)
#define PG8_SB(b, h) ((4 + (b) * 2 + (h)) * HTB)
#define PG8_STAGE(bufoff, gbase, voff) do { _Pragma("unroll") for (int _i = 0; _i < 2; ++_i) \
        __builtin_amdgcn_global_load_lds((const unsigned*)((const char*)(gbase) + (voff)[_i]), (PG8_LAS unsigned*)(lds + (bufoff) + ldsw + _i * 8192), 16, 0, 0); } while (0)
#define PG8_LDA(dst, b, h) do { _Pragma("unroll") for (int m = 0; m < 4; ++m) _Pragma("unroll") for (int k = 0; k < 2; ++k) dst[m][k] = *(const PG8_LAS bf16x8*)(lds + PG8_SA(b, h) + aoff + m * 2048 + k * 1024); } while (0)
#define PG8_LDB(dst, b, h) do { _Pragma("unroll") for (int n = 0; n < 2; ++n) _Pragma("unroll") for (int k = 0; k < 2; ++k) dst[n][k] = *(const PG8_LAS bf16x8*)(lds + PG8_SB(b, h) + boff + n * 2048 + k * 1024); } while (0)
#define PG8_MMA(ai, bj, At, Bt) do { __builtin_amdgcn_s_setprio(1); _Pragma("unroll") for (int m = 0; m < 4; ++m) _Pragma("unroll") for (int n = 0; n < 2; ++n) _Pragma("unroll") for (int k = 0; k < 2; ++k) \
        acc[ai][bj][m][n] = __builtin_amdgcn_mfma_f32_16x16x32_bf16(Bt[n][k], At[m][k], acc[ai][bj][m][n], 0, 0, 0); __builtin_amdgcn_s_setprio(0); } while (0)
#define PG8_WAIT_V(n) asm volatile("s_waitcnt vmcnt(" #n ")" ::: "memory")
#define PG8_WAIT_L(n) asm volatile("s_waitcnt lgkmcnt(" #n ")" ::: "memory")
#define PG8_BAR __builtin_amdgcn_s_barrier()
#define PG8_SCHED __builtin_amdgcn_sched_barrier(0)
    Unit cur, nxt; int ui = 0;
    if (!S.next(0, cur)) return;
    f32x4 acc[2][2][4][2];
#pragma unroll
    for (int a = 0; a < 2; ++a)
#pragma unroll
        for (int b = 0; b < 2; ++b)
#pragma unroll
            for (int m = 0; m < 4; ++m)
#pragma unroll
                for (int n = 0; n < 2; ++n) acc[a][b][m][n] = (f32x4){0.f, 0.f, 0.f, 0.f};
    bf16x8 At[4][2], B0[2][2], B1[2][2];
    const char* cA = (const char*)g.A + (size_t)cur.pm * tstep; const char* cB = (const char*)g.Bt + (size_t)cur.pn * tstep;
    S.a_ready(cur);
    if constexpr (SP2) {
        PG8_STAGE(PG8_SB(0, 0), cB, voffB); PG8_STAGE(PG8_SB(0, 1), cB + hstep, voffB); PG8_STAGE(PG8_SA(0, 0), cA, voffA); PG8_STAGE(PG8_SA(0, 1), cA + hstep, voffA);
        if (wr == 1) PG8_BAR;
        PG8_WAIT_V(2); PG8_BAR;
        PG8_STAGE(PG8_SB(1, 0), cB + kstep, voffB); PG8_STAGE(PG8_SA(1, 0), cA + kstep, voffA); PG8_STAGE(PG8_SB(1, 1), cB + hstep + kstep, voffB);
        PG8_WAIT_V(6); PG8_BAR;
    } else {
        PG8_STAGE(PG8_SB(0, 0), cB, voffB); PG8_STAGE(PG8_SA(0, 0), cA, voffA); PG8_STAGE(PG8_SB(0, 1), cB + hstep, voffB); PG8_STAGE(PG8_SA(0, 1), cA + hstep, voffA);
        if (wr == 1) PG8_BAR;
        PG8_WAIT_V(4); PG8_BAR;
        PG8_STAGE(PG8_SB(1, 0), cB + kstep, voffB); PG8_STAGE(PG8_SA(1, 0), cA + kstep, voffA); PG8_STAGE(PG8_SB(1, 1), cB + hstep + kstep, voffB);
        PG8_WAIT_V(6); PG8_BAR;
    }
    for (;;) {
        const bool has_next = S.next(ui + 1, nxt);
        const char* nA = has_next ? (const char*)g.A + (size_t)nxt.pm * tstep : cA; const char* nB = has_next ? (const char*)g.Bt + (size_t)nxt.pn * tstep : cB;
        for (int t = 0; t < nt; t += 2) {
            const bool last = (t == nt - 2);
            const char* a1 = cA + (size_t)(t + 1) * kstep;
            const char* a2 = last ? nA : cA + (size_t)(t + 2) * kstep; const char* b2 = last ? nB : cB + (size_t)(t + 2) * kstep;
            const char* a3 = a2 + kstep; const char* b3 = b2 + kstep;
            if (last && has_next) S.a_ready(nxt);
            if constexpr (SP2) {
            PG8_LDB(B0, 0, 0); PG8_LDB(B1, 0, 1); PG8_SCHED; PG8_LDA(At, 0, 0); PG8_STAGE(PG8_SA(1, 1), a1 + hstep, voffA);
            PG8_WAIT_V(8); PG8_WAIT_L(0); PG8_BAR; PG8_MMA(0, 0, At, B0); PG8_MMA(0, 1, At, B1); PG8_BAR; PG8_SCHED;
            PG8_LDA(At, 0, 1); PG8_STAGE(PG8_SB(0, 0), b2, voffB); PG8_STAGE(PG8_SB(0, 1), b2 + hstep, voffB); PG8_STAGE(PG8_SA(0, 0), a2, voffA);
            PG8_WAIT_V(8); PG8_WAIT_L(0); PG8_BAR; PG8_MMA(1, 0, At, B0); PG8_MMA(1, 1, At, B1); PG8_BAR; PG8_SCHED;
            PG8_LDB(B0, 1, 0); PG8_LDB(B1, 1, 1); PG8_SCHED; PG8_LDA(At, 1, 0); PG8_STAGE(PG8_SA(0, 1), a2 + hstep, voffA);
            PG8_WAIT_V(8); PG8_WAIT_L(0); PG8_BAR; PG8_MMA(0, 0, At, B0); PG8_MMA(0, 1, At, B1); PG8_BAR; PG8_SCHED;
            PG8_LDA(At, 1, 1); PG8_STAGE(PG8_SB(1, 0), b3, voffB); PG8_STAGE(PG8_SB(1, 1), b3 + hstep, voffB); PG8_STAGE(PG8_SA(1, 0), a3, voffA);
            PG8_WAIT_V(8); PG8_WAIT_L(0); PG8_BAR; PG8_MMA(1, 0, At, B0); PG8_MMA(1, 1, At, B1); PG8_BAR; PG8_SCHED;
            } else {
            PG8_LDB(B0, 0, 0); PG8_SCHED; PG8_LDA(At, 0, 0); PG8_STAGE(PG8_SA(1, 1), a1 + hstep, voffA);
            PG8_WAIT_L(8); PG8_BAR; PG8_WAIT_L(0); PG8_MMA(0, 0, At, B0); PG8_BAR; PG8_SCHED;
            PG8_LDB(B1, 0, 1); PG8_STAGE(PG8_SB(0, 0), b2, voffB);
            PG8_BAR; PG8_WAIT_L(0); PG8_MMA(0, 1, At, B1); PG8_BAR;
            PG8_LDA(At, 0, 1); PG8_STAGE(PG8_SA(0, 0), a2, voffA);
            PG8_BAR; PG8_WAIT_L(0); PG8_MMA(1, 0, At, B0); PG8_BAR; PG8_SCHED;
            PG8_STAGE(PG8_SB(0, 1), b2 + hstep, voffB);
            PG8_WAIT_V(6); PG8_BAR; PG8_MMA(1, 1, At, B1); PG8_BAR;
            PG8_LDB(B0, 1, 0); PG8_SCHED; PG8_LDA(At, 1, 0); PG8_STAGE(PG8_SA(0, 1), a2 + hstep, voffA);
            PG8_WAIT_L(8); PG8_BAR; PG8_WAIT_L(0); PG8_MMA(0, 0, At, B0); PG8_BAR; PG8_SCHED;
            PG8_LDB(B1, 1, 1); PG8_STAGE(PG8_SB(1, 0), b3, voffB);
            PG8_BAR; PG8_WAIT_L(0); PG8_MMA(0, 1, At, B1); PG8_BAR;
            PG8_LDA(At, 1, 1); PG8_STAGE(PG8_SA(1, 0), a3, voffA);
            PG8_BAR; PG8_WAIT_L(0); PG8_MMA(1, 0, At, B0); PG8_BAR; PG8_SCHED;
            PG8_STAGE(PG8_SB(1, 1), b3 + hstep, voffB);
            PG8_WAIT_V(6); PG8_BAR; PG8_MMA(1, 1, At, B1); PG8_BAR;
            }
        }
        if constexpr (ALIGN_EPI) { if (wr == 0) PG8_BAR; }
        if constexpr (!Epi::AFTER_DRAIN) { E(acc, cur, wr, wc, fr, fq); S.done(cur); }
        if (!has_next) break;
#pragma unroll
        for (int a = 0; a < 2; ++a)
#pragma unroll
            for (int b = 0; b < 2; ++b)
#pragma unroll
                for (int m = 0; m < 4; ++m)
#pragma unroll
                    for (int n = 0; n < 2; ++n) acc[a][b][m][n] = (f32x4){0.f, 0.f, 0.f, 0.f};
        cur = nxt; cA = nA; cB = nB; ++ui;
        if constexpr (ALIGN_EPI) { if (wr == 1) PG8_BAR; }
    }
    PG8_WAIT_V(0);
    if constexpr (!ALIGN_EPI) { if (wr == 0) PG8_BAR; }
    PG8_BAR;
    if constexpr (Epi::AFTER_DRAIN) { E.fused(acc, cur, wr, wc, fr, fq, lds, wid, lane); S.done(cur); }
#undef PG8_SA
#undef PG8_SB
#undef PG8_STAGE
#undef PG8_LDA
#undef PG8_LDB
#undef PG8_MMA
#undef PG8_WAIT_V
#undef PG8_WAIT_L
#undef PG8_BAR
#undef PG8_SCHED
}
}

namespace att {
using bf16x8 = __attribute__((ext_vector_type(8))) short;
using s16x4 = __attribute__((ext_vector_type(4))) short;
using f32x16 = __attribute__((ext_vector_type(16))) float;
using u32x4 = __attribute__((ext_vector_type(4))) unsigned;
typedef short v4i16_t __attribute__((ext_vector_type(4)));
typedef __attribute__((address_space(3))) const char* lds_cptr;
constexpr int NW = 8, QB = 256, KVBLK = 64, NT = SEQ / KVBLK;
constexpr int NSLOT = 4, SLOTB = 8192;
constexpr int LDS_K = 0, LDS_V = NSLOT * SLOTB, LDS_WS = 2 * NSLOT * SLOTB, LDS_OST = LDS_WS + NW * 128 * 4, LDS_BYTES = LDS_OST + NW * 32 * 64 * 4;
__device__ __forceinline__ int crow(int r, int hi) { return (r & 3) + 8 * (r >> 2) + 4 * hi; }
__device__ __forceinline__ void glds16(const void* gsrc, unsigned lds_dst) { unsigned keep;
    asm volatile("s_mov_b32 %0, m0\n\ts_mov_b32 m0, %2\n\ts_nop 0\n\tglobal_load_lds_dwordx4 %1, off\n\ts_mov_b32 m0, %0" : "=&s"(keep) : "v"(gsrc), "s"(lds_dst) : "memory"); }
typedef float f32x2_t __attribute__((ext_vector_type(2))); typedef __bf16 bf16x2_t __attribute__((ext_vector_type(2)));
__device__ __forceinline__ unsigned cvtpk_s(float lo, float hi) { f32x2_t v = {lo, hi}; bf16x2_t b = __builtin_convertvector(v, bf16x2_t); return __builtin_bit_cast(unsigned, b); }
__device__ __forceinline__ s16x4 vtr(lds_cptr p) { return __builtin_bit_cast(s16x4, __builtin_amdgcn_ds_read_tr16_b64_v4i16((__attribute__((address_space(3))) v4i16_t*)p)); }
#define ATT_WAIT_BAR(N) asm volatile("s_waitcnt vmcnt(" #N ") lgkmcnt(0)\n\ts_barrier" ::: "memory")

__device__ __forceinline__ float max3f(float a, float b, float c) { float r; asm("v_max3_f32 %0, %1, %2, %3" : "=v"(r) : "v"(a), "v"(b), "v"(c)); return r; }
__device__ __forceinline__ float fadd_s(float a, float b) { float r; asm("v_add_f32_e32 %0, %1, %2" : "=v"(r) : "v"(a), "v"(b)); return r; }
__device__ __forceinline__ float max2f(float a, float b) { float r; asm("v_max_f32_e32 %0, %1, %2" : "=v"(r) : "v"(a), "v"(b)); return r; }
#define ATT_DIAG_BIAS(s0, s1) do { const float dqh_ = dq - (float)(4 * hi); _Pragma("unroll") for (int r = 0; r < 16; ++r) { const float c_ = (float)((r & 3) + 8 * (r >> 2)); \
        s0[r] = __builtin_fmaf(-sl, __builtin_fabsf(dqh_ - c_), s0[r]); s1[r] = __builtin_fmaf(-sl, __builtin_fabsf(dqh_ - (c_ + 32.f)), s1[r]); } } while (0)
template <bool FIRST>
__device__ __forceinline__ float softmax_exact(f32x16& s0, f32x16& s1, float& mhat, float& lreg, f32x16& o0, f32x16& o1, float* wsf_f, const int r32, const int hi) {
    float ra = max3f(s0[0], s0[1], s1[0]), rb = max3f(s0[2], s0[3], s1[1]); ra = max3f(ra, s1[2], s1[3]);
#pragma unroll
    for (int r = 4; r < 16; r += 4) { ra = max3f(ra, s0[r], s0[r + 1]); rb = max3f(rb, s0[r + 2], s0[r + 3]); ra = max3f(ra, s1[r], s1[r + 1]); rb = max3f(rb, s1[r + 2], s1[r + 3]); }
    float rm = max2f(ra, rb);
    { auto rr = __builtin_amdgcn_permlane32_swap(__float_as_uint(rm), __float_as_uint(rm), false, false); rm = max2f(__uint_as_float(rr[0]), __uint_as_float(rr[1])); }
    const float dl = FIRST ? rm : max2f(rm, 0.f);
    mhat += dl;
    if (!FIRST) {
        const float f = __builtin_amdgcn_exp2f(-dl); lreg *= f;
        if (hi == 0) wsf_f[r32] = f;
        asm volatile("s_waitcnt lgkmcnt(0)" ::: "memory");
#pragma unroll
        for (int r = 0; r < 16; ++r) { const float fr = wsf_f[crow(r, hi)]; o0[r] *= fr; o1[r] *= fr; }
        asm volatile("" ::: "memory");
    }
    float sacc = 0.f;
#pragma unroll
    for (int r = 0; r < 16; ++r) { s0[r] = __builtin_amdgcn_exp2f(s0[r] - dl); s1[r] = __builtin_amdgcn_exp2f(s1[r] - dl); sacc += s0[r] + s1[r]; }
    return sacc;
}
#define ATT_PIN(x) asm volatile("" : "+v"(x))
#define ATT_EXPSUM(s0, s1, acc) do { float c0_ = 0.f, c1_ = 0.f, c2_ = 0.f, c3_ = 0.f; \
    _Pragma("unroll") for (int r = 0; r < 16; r += 2) { s0[r] = __builtin_amdgcn_exp2f(s0[r]); s1[r] = __builtin_amdgcn_exp2f(s1[r]); s0[r + 1] = __builtin_amdgcn_exp2f(s0[r + 1]); s1[r + 1] = __builtin_amdgcn_exp2f(s1[r + 1]); \
        c0_ += s0[r]; ATT_PIN(c0_); c1_ += s1[r]; ATT_PIN(c1_); c2_ += s0[r + 1]; ATT_PIN(c2_); c3_ += s1[r + 1]; ATT_PIN(c3_); } \
    c0_ += c1_; ATT_PIN(c0_); c2_ += c3_; ATT_PIN(c2_); acc = c0_ + c2_; } while (0)
#define ATT_PACK(s0, s1, pw0, pw1, pw2, pw3) do { \
    pw0 = (u32x4){cvtpk_s(s0[0], s0[1]), cvtpk_s(s0[2], s0[3]), cvtpk_s(s0[4], s0[5]), cvtpk_s(s0[6], s0[7])}; \
    pw1 = (u32x4){cvtpk_s(s0[8], s0[9]), cvtpk_s(s0[10], s0[11]), cvtpk_s(s0[12], s0[13]), cvtpk_s(s0[14], s0[15])}; \
    pw2 = (u32x4){cvtpk_s(s1[0], s1[1]), cvtpk_s(s1[2], s1[3]), cvtpk_s(s1[4], s1[5]), cvtpk_s(s1[6], s1[7])}; \
    pw3 = (u32x4){cvtpk_s(s1[8], s1[9]), cvtpk_s(s1[10], s1[11]), cvtpk_s(s1[12], s1[13]), cvtpk_s(s1[14], s1[15])}; } while (0)
__device__ __forceinline__ float bfr(float x) { return __uint_as_float(cvtpk_s(x, 0.f) << 16); }
__device__ __forceinline__ bf16x8 make_qaug(const float a, const float sgs1, const unsigned w2, const unsigned h0, const unsigned h1, const int hi) {
    const float r1 = a - bfr(a), r2 = r1 - bfr(r1);
    u32x4 w; w.x = cvtpk_s(a, r1); w.y = cvtpk_s(r2, sgs1); w.z = w2; w.w = 0u;
    if (hi) { w.x = h0; w.y = h1; w.z = 0u; }
    return __builtin_bit_cast(bf16x8, w);
}

template <int THRL, int SKIP_T, int ABL = 0>
__device__ __forceinline__ void attn_unit(const int b, const int h, const int qb, const bf16_t* __restrict__ proj, bf16_t* __restrict__ mix, const float* __restrict__ gsub,
                                          const float lam, const float oscale, const unsigned* __restrict__ kn2, char* shm) {
    const int tid = launder_v((int)threadIdx.x), lane = tid & 63, r32 = lane & 31, hi = lane >> 5; const int wid = __builtin_amdgcn_readfirstlane(tid >> 6);
    const int grp = wid >> 2;
    const long rowbase = (long)b * SEQ; const int q0 = qb * QB;
    const float sl0 = __builtin_amdgcn_exp2f(-(float)(h + 1)) * LOG2E;
    const float s1 = bfr(sl0), s2 = bfr(sl0 - s1), s3 = bfr(sl0 - s1 - s2); const float sl = s1 + s2 + s3;
    const bf16_t* Qw = proj + (rowbase + q0 + wid * 32) * INW + O_Q + h * 64;
    const bf16_t* Kh = proj + rowbase * INW + O_K + h * 64; const bf16_t* Vh = proj + rowbase * INW + O_V + h * 64;
    const unsigned lds0 = (unsigned)(uintptr_t)shm;
    float* wsf = (float*)(shm + LDS_WS) + wid * 128;
    const bf16_t* ksrc = Kh + (long)(16 * (wid & 3) + (lane >> 2)) * INW + (wid >> 2) * 32 + (((lane & 3) ^ ((lane >> 4) & 3))) * 8;
    const bf16_t* vsrc = Vh + (long)(16 * (wid & 3) + (lane >> 2)) * INW + (wid >> 2) * 32 + (lane & 3) * 8;
    const unsigned kdst = lds0 + LDS_K + wid * 1024, vdst = lds0 + LDS_V + wid * 1024;
    const int d0t = 4 * qb;
    int nR = NT - d0t, NTe = NT;
    const int td = d0t + (wid >> 1);
#define ATT_TAU(i) ((i) < nR ? d0t + (i) : d0t - 1 - ((i) - nR))
#define ATT_DMA(i, slot) do { if (ABL & 1) break; const long off_ = (long)ATT_TAU(i) * KVBLK * INW; \
        glds16(ksrc + off_, (unsigned)__builtin_amdgcn_readfirstlane(kdst + (slot) * SLOTB)); glds16(vsrc + off_, (unsigned)__builtin_amdgcn_readfirstlane(vdst + (slot) * SLOTB)); } while (0)
#define ATT_BARV(N) do { if (ABL & 16) asm volatile("s_waitcnt vmcnt(" #N ") lgkmcnt(0)\n\ts_nop 11" ::: "memory"); else asm volatile("s_waitcnt vmcnt(" #N ") lgkmcnt(0)\n\ts_barrier\n\ts_nop 11" ::: "memory"); } while (0)
#define ATT_BAR() do { if (ABL & 16) asm volatile("s_waitcnt lgkmcnt(0)" ::: "memory"); else asm volatile("s_waitcnt lgkmcnt(0)\n\ts_barrier" ::: "memory"); } while (0)
#define ATT_SB() __builtin_amdgcn_sched_barrier(0)
    bf16x8 qr[4];
#pragma unroll
    for (int d0 = 0; d0 < 4; ++d0) qr[d0] = *reinterpret_cast<const bf16x8*>(&Qw[(long)r32 * INW + d0 * 16 + hi * 8]);
    float ka2 = 0.f, kb2 = 0.f;
    if (SKIP_T > 0) { const unsigned* knp = kn2 + ((b * 8 + h) * 2) * 64;
        ka2 = __uint_as_float(__hip_atomic_load(knp + lane, __ATOMIC_RELAXED, __HIP_MEMORY_SCOPE_AGENT)); kb2 = __uint_as_float(__hip_atomic_load(knp + 64 + lane, __ATOMIC_RELAXED, __HIP_MEMORY_SCOPE_AGENT)); }
    const bf16_t* Kq = Kh + (long)(q0 + wid * 32 + r32) * INW + hi * 8;
    bf16x8 kk[4];
    if (SKIP_T > 0) {
#pragma unroll
        for (int d0 = 0; d0 < 4; ++d0) kk[d0] = *reinterpret_cast<const bf16x8*>(Kq + d0 * 16); }
    ATT_DMA(0, 0); ATT_DMA(1, 1);
    float dra = 0.f, drb = 0.f;
    if (SKIP_T > 0) {
        float qa2 = 0.f, qb2 = 0.f;
#pragma unroll
        for (int d0 = 0; d0 < 4; ++d0) {
#pragma unroll
            for (int j = 0; j < 8; ++j) { const float qv = bf2f((bf16_t)qr[d0][j]), kv = bf2f((bf16_t)kk[d0][j]); if (d0 < 2) { qa2 += qv * qv; dra += qv * kv; } else { qb2 += qv * qv; drb += qv * kv; } } }
        qa2 += __shfl_xor(qa2, 32); qb2 += __shfl_xor(qb2, 32); dra += __shfl_xor(dra, 32); drb += __shfl_xor(drb, 32);
#pragma unroll
        for (int o = 1; o < 32; o <<= 1) { qa2 = fmaxf(qa2, __shfl_xor(qa2, o)); qb2 = fmaxf(qb2, __shfl_xor(qb2, o)); }
        if (lane == 0) { wsf[0] = qa2; wsf[1] = qb2; }
    }
    { __attribute__((address_space(3))) bf16x8* qst_ = (__attribute__((address_space(3))) bf16x8*)((lds_cptr)shm + LDS_OST + wid * 8192) + lane;
#pragma unroll
      for (int d0 = 0; d0 < 4; ++d0) qst_[d0 * 64] = qr[d0]; }
    const lds_cptr qp = (lds_cptr)shm + LDS_OST + wid * 8192 + lane * 16;
#define ATT_LDQ() const bf16x8 qf0 = *(const __attribute__((address_space(3))) bf16x8*)(qp), qf1 = *(const __attribute__((address_space(3))) bf16x8*)(qp + 1024), qf2 = *(const __attribute__((address_space(3))) bf16x8*)(qp + 2048), qf3 = *(const __attribute__((address_space(3))) bf16x8*)(qp + 3072)
    bf16x8 kaug0, kaug1;
    { const unsigned sb0 = (unsigned)f2bf((float)r32), sb1 = (unsigned)f2bf((float)(r32 + 32));
      u32x4 w0 = (u32x4){0x3F803F80u, (sb0 << 16) | 0x3F80u, (sb0 << 16) | sb0, 0u}, w1 = (u32x4){0x3F803F80u, (sb1 << 16) | 0x3F80u, (sb1 << 16) | sb1, 0u};
      if (hi) { w0 = (u32x4){0u, 0u, 0u, 0u}; w1 = w0; }
      kaug0 = __builtin_bit_cast(bf16x8, w0); kaug1 = __builtin_bit_cast(bf16x8, w1); }
    const unsigned w2pos = cvtpk_s(s2, s3), w2neg = cvtpk_s(-s2, -s3), h0pos = cvtpk_s(s1, s2), h0neg = cvtpk_s(-s1, -s2), h1pos = cvtpk_s(s3, 0.f), h1neg = cvtpk_s(-s3, 0.f);
    float mhatA = 0.f, mhatB = 0.f, lA = 0.f, lB = 0.f;
    f32x16 oa0 = f32x16{}, oa1 = f32x16{}, ob0 = f32x16{}, ob1 = f32x16{};
    f32x16 sa0, sa1, sb0, sb1;
    u32x4 pa0, pa1, pa2, pa3, pb0, pb1, pb2, pb3;
    bf16x8 qaA, qaB;
    const lds_cptr shm3 = (lds_cptr)shm;
    const lds_cptr kp0 = (lds_cptr)shm + LDS_K + (r32 >> 4) * 1024 + (r32 & 15) * 64 + ((hi) ^ ((r32 >> 2) & 3)) * 16;
    const int koB = (((2 + hi) ^ ((r32 >> 2) & 3)) - ((hi) ^ ((r32 >> 2) & 3))) * 16;
    const lds_cptr vp0 = shm3 + LDS_V + ((lane >> 4) & 1) * 32 + (lane & 3) * 8 + (4 * hi + ((lane & 15) >> 2)) * 64;
    const int tq = q0 + wid * 32 + r32;
    const f32x16 zero = f32x16{};
#define ATT_KA(off) (*(const __attribute__((address_space(3))) bf16x8*)(kp + (off)))
#define ATT_KB(off) (*(const __attribute__((address_space(3))) bf16x8*)(kp + koB + (off)))
#define ATT_VFR(n, ks) const s16x4 l0##n = vtr(vp + (ks) * 1024), h0##n = vtr(vp + (ks) * 1024 + 512), l1##n = vtr(vp + 4096 + (ks) * 1024), h1##n = vtr(vp + 4096 + (ks) * 1024 + 512)
#define ATT_PVK(n, PA, PB) do { if (ABL & 4) { asm volatile("" :: "v"(l0##n), "v"(h0##n), "v"(l1##n), "v"(h1##n), "v"(PA), "v"(PB)); break; } const bf16x8 v0_ = (bf16x8){l0##n[0], l0##n[1], l0##n[2], l0##n[3], h0##n[0], h0##n[1], h0##n[2], h0##n[3]}, v1_ = (bf16x8){l1##n[0], l1##n[1], l1##n[2], l1##n[3], h1##n[0], h1##n[1], h1##n[2], h1##n[3]}; \
        const bf16x8 pa_ = __builtin_bit_cast(bf16x8, PA), pb_ = __builtin_bit_cast(bf16x8, PB); \
        oa0 = __builtin_amdgcn_mfma_f32_32x32x16_bf16(pa_, v0_, oa0, 0, 0, 0); oa1 = __builtin_amdgcn_mfma_f32_32x32x16_bf16(pa_, v1_, oa1, 0, 0, 0); \
        ob0 = __builtin_amdgcn_mfma_f32_32x32x16_bf16(pb_, v0_, ob0, 0, 0, 0); ob1 = __builtin_amdgcn_mfma_f32_32x32x16_bf16(pb_, v1_, ob1, 0, 0, 0); } while (0)
#define ATT_QKA() do { if (ABL & 8) { asm volatile("" : "+v"(sa0), "+v"(sa1) : "v"(ka0), "v"(ka1), "v"(ka2), "v"(ka3), "v"(qaA)); break; } sa0 = __builtin_amdgcn_mfma_f32_32x32x16_bf16(kaug0, qaA, zero, 0, 0, 0); sa1 = __builtin_amdgcn_mfma_f32_32x32x16_bf16(kaug1, qaA, zero, 0, 0, 0); \
        sa0 = __builtin_amdgcn_mfma_f32_32x32x16_bf16(ka0, qf0, sa0, 0, 0, 0); sa1 = __builtin_amdgcn_mfma_f32_32x32x16_bf16(ka1, qf0, sa1, 0, 0, 0); \
        sa0 = __builtin_amdgcn_mfma_f32_32x32x16_bf16(ka2, qf1, sa0, 0, 0, 0); sa1 = __builtin_amdgcn_mfma_f32_32x32x16_bf16(ka3, qf1, sa1, 0, 0, 0); } while (0)
#define ATT_QKB() do { if (ABL & 8) { asm volatile("" : "+v"(sb0), "+v"(sb1) : "v"(kb0), "v"(kb1), "v"(kb2), "v"(kb3), "v"(qaB)); break; } sb0 = __builtin_amdgcn_mfma_f32_32x32x16_bf16(kaug0, qaB, zero, 0, 0, 0); sb1 = __builtin_amdgcn_mfma_f32_32x32x16_bf16(kaug1, qaB, zero, 0, 0, 0); \
        sb0 = __builtin_amdgcn_mfma_f32_32x32x16_bf16(kb0, qf2, sb0, 0, 0, 0); sb1 = __builtin_amdgcn_mfma_f32_32x32x16_bf16(kb1, qf2, sb1, 0, 0, 0); \
        sb0 = __builtin_amdgcn_mfma_f32_32x32x16_bf16(kb2, qf3, sb0, 0, 0, 0); sb1 = __builtin_amdgcn_mfma_f32_32x32x16_bf16(kb3, qf3, sb1, 0, 0, 0); } while (0)
#define ATT_SIDE(tau_) ((tau_) < td ? 0 : ((tau_) == td ? 1 : 2))
#define ATT_QAUG(sd_) do { const bool left_ = (sd_) == 0, diag_ = (sd_) == 1; const float tsl = sl * (float)tq;     \
        const float aA_ = diag_ ? -mhatA : (left_ ? -tsl - mhatA : tsl - mhatA), aB_ = diag_ ? -mhatB : (left_ ? -tsl - mhatB : tsl - mhatB); \
        const float sgs1_ = diag_ ? 0.f : (left_ ? s1 : -s1); const unsigned w2_ = diag_ ? 0u : (left_ ? w2pos : w2neg), h0_ = diag_ ? 0u : (left_ ? h0pos : h0neg), h1_ = diag_ ? 0u : (left_ ? h1pos : h1neg); \
        qaA = make_qaug(aA_, sgs1_, w2_, h0_, h1_, hi); qaB = make_qaug(aB_, sgs1_, w2_, h0_, h1_, hi); } while (0)
#define ATT_KAUG(tau_) do { const unsigned tb_ = __float_as_uint((float)((tau_) * KVBLK)) >> 16; \
        if (hi) { const u32x4 w_ = (u32x4){tb_ | (tb_ << 16), tb_, 0u, 0u}; kaug0 = __builtin_bit_cast(bf16x8, w_); kaug1 = kaug0; } } while (0)
    ATT_QAUG(ATT_SIDE(d0t)); ATT_KAUG(d0t);
    ATT_BARV(2);
    { ATT_DMA(2, 2);
      const lds_cptr kp = kp0;
      const bf16x8 ka0 = ATT_KA(0), ka1 = ATT_KA(2048), ka2 = ATT_KB(0), ka3 = ATT_KB(2048), kb0 = ATT_KA(4096), kb1 = ATT_KA(6144), kb2 = ATT_KB(4096), kb3 = ATT_KB(6144);
      ATT_LDQ();
      ATT_QKA(); ATT_QKB();
      ATT_SB(); ATT_BARV(2); ATT_SB();
      const bool diag = d0t == td; const float dq = (float)(tq - d0t * KVBLK);
      if (ABL & 2) { asm volatile("" : "=v"(pa0), "=v"(pa1), "=v"(pa2), "=v"(pa3), "=v"(pb0), "=v"(pb1), "=v"(pb2), "=v"(pb3) : "v"(sa0), "v"(sa1), "v"(sb0), "v"(sb1)); } else {
      if (diag) { ATT_DIAG_BIAS(sa0, sa1); ATT_DIAG_BIAS(sb0, sb1); }
      lA = softmax_exact<true>(sa0, sa1, mhatA, lA, oa0, oa1, wsf, r32, hi); lB = softmax_exact<true>(sb0, sb1, mhatB, lB, ob0, ob1, wsf + 32, r32, hi);
      if (SKIP_T > 0) { float la = fmaxf(mhatA, dra), lb = fmaxf(mhatB, drb);
#pragma unroll
          for (int o = 1; o < 32; o <<= 1) { la = fminf(la, __shfl_xor(la, o)); lb = fminf(lb, __shfl_xor(lb, o)); }
          if (lane == 0) { wsf[2] = la; wsf[3] = lb; } }
      ATT_PACK(sa0, sa1, pa0, pa1, pa2, pa3); ATT_PACK(sb0, sb1, pb0, pb1, pb2, pb3); }
      { const int tn_ = ATT_TAU(1); ATT_QAUG(ATT_SIDE(tn_)); ATT_KAUG(tn_); }
      ATT_SB(); ATT_BAR(); ATT_SB(); }
    if (SKIP_T > 0) {
        float qa2 = 0.f, qb2 = 0.f, da = 3.0e38f, db = 3.0e38f;
        { const float* wall = (const float*)(shm + LDS_WS);
#pragma unroll
          for (int w = 0; w < NW; ++w) { qa2 = fmaxf(qa2, wall[w * 128 + 0]); qb2 = fmaxf(qb2, wall[w * 128 + 1]); da = fminf(da, wall[w * 128 + 2]); db = fminf(db, wall[w * 128 + 3]); } }
        const int kt0 = lane * KVBLK; const int dmin = kt0 + KVBLK - 1 < q0 ? q0 - (kt0 + KVBLK - 1) : (kt0 > q0 + QB - 1 ? kt0 - (q0 + QB - 1) : 0);
        const float pen = sl * (float)dmin - (float)SKIP_T;
        const bool needed = dmin == 0 || !(sqrtf(qa2 * ka2) * 1.01f - pen <= da) || !(sqrtf(qb2 * kb2) * 1.01f - pen <= db);
        const unsigned long long mask = __ballot(needed);
        const int tR = 63 - __clzll((long long)mask), tL = __ffsll((long long)mask) - 1;
        nR = __builtin_amdgcn_readfirstlane(tR + 1 - d0t); NTe = __builtin_amdgcn_readfirstlane(tR - tL + 1);
        ATT_BAR();
    }
    if (grp == 1) { ATT_BAR(); }
    for (int i = 1; i < NTe; ++i) {
        const int tau = ATT_TAU(i), slot = i & 3;
        { const int id_ = i + 2 < NTe ? i + 2 : NTe - 1; ATT_DMA(id_, (i + 2) & 3); }
        { const lds_cptr vp = vp0 + ((i - 1) & 3) * SLOTB, kp = kp0 + slot * SLOTB;
          ATT_VFR(a, 0); ATT_VFR(b, 1);
          const bf16x8 ka0 = ATT_KA(0), ka1 = ATT_KA(2048), ka2 = ATT_KB(0), ka3 = ATT_KB(2048);
          ATT_SB();
          ATT_PVK(a, pa0, pb0); ATT_SB();
          ATT_VFR(c, 2); ATT_SB();
          ATT_PVK(b, pa1, pb1); ATT_SB();
          ATT_VFR(d, 3);
          const bf16x8 kb0 = ATT_KA(4096), kb1 = ATT_KA(6144), kb2 = ATT_KB(4096), kb3 = ATT_KB(6144);
          ATT_LDQ();
          ATT_SB();
          ATT_PVK(c, pa2, pb2); ATT_SB();
          ATT_PVK(d, pa3, pb3); ATT_SB();
          ATT_QKA(); ATT_QKB(); }
        ATT_SB();
        ATT_BARV(2);
        __builtin_amdgcn_s_setprio(1);
        ATT_SB();
        { const bool diag = tau == td; const float dq = (float)(tq - tau * KVBLK);
          if (ABL & 2) { asm volatile("" : "=v"(pa0), "=v"(pa1), "=v"(pa2), "=v"(pa3), "=v"(pb0), "=v"(pb1), "=v"(pb2), "=v"(pb3) : "v"(sa0), "v"(sa1), "v"(sb0), "v"(sb1)); } else {
          if (diag) { ATT_DIAG_BIAS(sa0, sa1); ATT_DIAG_BIAS(sb0, sb1); }
          const float big = (float)(1u << THRL);
          bool redo = false;
          { float accA; ATT_EXPSUM(sa0, sa1, accA);
            if (__builtin_expect(__any(!(accA < big)), 0)) { const lds_cptr kp = kp0 + slot * SLOTB;
                const bf16x8 ka0 = ATT_KA(0), ka1 = ATT_KA(2048), ka2 = ATT_KB(0), ka3 = ATT_KB(2048);
                ATT_LDQ();
                ATT_QKA(); asm volatile("s_nop 15\n\ts_nop 7" : "+v"(sa0), "+v"(sa1)); if (diag) ATT_DIAG_BIAS(sa0, sa1);
                accA = softmax_exact<false>(sa0, sa1, mhatA, lA, oa0, oa1, wsf, r32, hi); redo = true; }
            lA += accA; ATT_PACK(sa0, sa1, pa0, pa1, pa2, pa3); }
          ATT_SB();
          { float accB; ATT_EXPSUM(sb0, sb1, accB);
            if (__builtin_expect(__any(!(accB < big)), 0)) { const lds_cptr kp = kp0 + slot * SLOTB;
                const bf16x8 kb0 = ATT_KA(4096), kb1 = ATT_KA(6144), kb2 = ATT_KB(4096), kb3 = ATT_KB(6144);
                ATT_LDQ();
                ATT_QKB(); asm volatile("s_nop 15\n\ts_nop 7" : "+v"(sb0), "+v"(sb1)); if (diag) ATT_DIAG_BIAS(sb0, sb1);
                accB = softmax_exact<false>(sb0, sb1, mhatB, lB, ob0, ob1, wsf + 32, r32, hi); redo = true; }
            lB += accB; ATT_PACK(sb0, sb1, pb0, pb1, pb2, pb3); }
          { const int in_ = i + 1 < NTe ? i + 1 : i; const int tn_ = ATT_TAU(in_); const int sdn_ = ATT_SIDE(tn_);
            if (redo || sdn_ != ATT_SIDE(tau)) { ATT_QAUG(sdn_); }
            ATT_KAUG(tn_); } } }
        __builtin_amdgcn_s_setprio(0);
        ATT_SB(); ATT_BAR(); ATT_SB();
    }
    { const lds_cptr vp = vp0 + ((NTe - 1) & 3) * SLOTB;
      ATT_VFR(a, 0); ATT_VFR(b, 1); ATT_VFR(c, 2); ATT_VFR(d, 3);
      ATT_PVK(a, pa0, pb0); ATT_PVK(b, pa1, pb1); ATT_PVK(c, pa2, pb2); ATT_PVK(d, pa3, pb3); }
    ATT_BAR();
    if (grp == 0) { ATT_BAR(); }
    { auto rr = __builtin_amdgcn_permlane32_swap(__float_as_uint(lA), __float_as_uint(lA), false, false); lA = __uint_as_float(rr[0]) + __uint_as_float(rr[1]); }
    { auto rr = __builtin_amdgcn_permlane32_swap(__float_as_uint(lB), __float_as_uint(lB), false, false); lB = __uint_as_float(rr[0]) + __uint_as_float(rr[1]); }
    if (hi == 0) { wsf[64 + r32] = 1.f / lA; wsf[96 + r32] = lam / lB; }
    asm volatile("s_waitcnt lgkmcnt(0)" ::: "memory");
    float* stg = (float*)(shm + LDS_OST) + wid * 2048;
#pragma unroll
    for (int r = 0; r < 16; ++r) { const int orow = crow(r, hi); const float a = wsf[64 + orow], c = wsf[96 + orow];
        stg[orow * 64 + r32] = oa0[r] * a - ob0[r] * c; stg[orow * 64 + 32 + r32] = oa1[r] * a - ob1[r] * c; }
    asm volatile("s_waitcnt lgkmcnt(0)" ::: "memory");
    bf16_t* Ow = mix + (rowbase + q0 + wid * 32) * D + h * 64;
    const int ch = lane & 7;
    const float4 g0 = *(const float4*)(gsub + ch * 8), g1 = *(const float4*)(gsub + ch * 8 + 4);
#pragma unroll
    for (int i = 0; i < 4; ++i) { const int row = i * 8 + (lane >> 3);
        const float4 a = *(const float4*)(stg + row * 64 + ch * 8), c = *(const float4*)(stg + row * 64 + ch * 8 + 4);
        float ss = a.x * a.x + a.y * a.y + a.z * a.z + a.w * a.w + c.x * c.x + c.y * c.y + c.z * c.z + c.w * c.w;
        ss += __shfl_xor(ss, 1); ss += __shfl_xor(ss, 2); ss += __shfl_xor(ss, 4);
        const float rn = rsqrtf(ss * (1.f / 64.f) + EPS) * oscale;
        u32x4 w; w.x = cvtpk_s(a.x * rn * g0.x, a.y * rn * g0.y); w.y = cvtpk_s(a.z * rn * g0.z, a.w * rn * g0.w); w.z = cvtpk_s(c.x * rn * g1.x, c.y * rn * g1.y); w.w = cvtpk_s(c.z * rn * g1.z, c.w * rn * g1.w);
        *(u32x4*)(Ow + (long)row * D + ch * 8) = w; }
    asm volatile("s_waitcnt lgkmcnt(0)" ::: "memory");
#undef ATT_TAU
#undef ATT_DMA
#undef ATT_BARV
#undef ATT_BAR
#undef ATT_SB
#undef ATT_KA
#undef ATT_KB
#undef ATT_LDQ
#undef ATT_VFR
#undef ATT_PVK
#undef ATT_QKA
#undef ATT_QKB
#undef ATT_QAUG
#undef ATT_KAUG
#undef ATT_SIDE
}
#undef ATT_WAIT_BAR
#undef ATT_DIAG_BIAS
#undef ATT_PACK
#undef ATT_EXPSUM
#undef ATT_PIN
}

constexpr int NWAVES = 8, NTHR = NWAVES * 64;
constexpr int RING_BYTES = 139264;
constexpr int MISC_OFF = RING_BYTES;
constexpr int LDS_BYTES = 147456;
static_assert(MISC_OFF + 128 <= LDS_BYTES && att::LDS_BYTES <= RING_BYTES, "LDS map");

__device__ __forceinline__ float wave_sum(float v) {
#pragma unroll
    for (int o = 1; o < 64; o <<= 1) v += __shfl_xor(v, o);
    return v;
}
__device__ __forceinline__ void p0_transpose_item(const float* __restrict__ W, int K, int N, bf16_t* __restrict__ WT, int k0, int n0, int dst_row0, LAS float* scr, int lane) {
    float4 v[16]; const int kr = lane >> 4, c4 = (lane & 15) * 4;
#pragma unroll
    for (int i = 0; i < 16; ++i) v[i] = *(const float4*)(W + (size_t)(k0 + 4 * i + kr) * N + n0 + c4);
#pragma unroll
    for (int i = 0; i < 16; ++i) { LAS float* d = scr + (4 * i + kr) * 65 + c4; d[0] = v[i].x; d[1] = v[i].y; d[2] = v[i].z; d[3] = v[i].w; }
    LDS_WAIT(); asm volatile("" ::: "memory");
    const int c = lane & 7;
#pragma unroll
    for (int j = 0; j < 8; ++j) { const int n = (lane >> 3) + 8 * j; const LAS float* s = scr + (8 * c) * 65 + n;
        uint4 o; o.x = pk2(s[0 * 65], s[1 * 65]); o.y = pk2(s[2 * 65], s[3 * 65]); o.z = pk2(s[4 * 65], s[5 * 65]); o.w = pk2(s[6 * 65], s[7 * 65]);
        *(uint4*)(WT + (size_t)(dst_row0 + n) * K + k0 + 8 * c) = o; }
    LDS_WAIT(); asm volatile("" ::: "memory");
}
__device__ __forceinline__ void p0_transpose_matrix(const float* W, int K, int N, bf16_t* WT, bool interleave, LAS float* scr, int gw, int ngw, int lane, int& cursor) {
    const int nkb = K / 64, nnb = N / 64, nitems = nkb * nnb;
    int first = ((gw - cursor) % ngw + ngw) % ngw;
    for (int it = first; it < nitems; it += ngw) { const int kb = it / nnb, nb = it % nnb; const int n0 = nb * 64;
        int dr = n0; if (interleave) { const int j = n0 < DFF ? n0 : n0 - DFF; dr = (j / 128) * 256 + (j % 128) + (n0 < DFF ? 0 : 128); }
        p0_transpose_item(W, K, N, WT, kb * 64, n0, dr, scr, lane); }
    cursor += nitems;
}
__device__ __forceinline__ void p0_mod_unit(const float* __restrict__ c, const float* __restrict__ w_ada, const float* __restrict__ b_ada, float* __restrict__ mod, int unit, LAS float* lds, int tid) {
    LAS float* sc = lds;
    LAS float* red = lds + 8192;
    const int l = unit / 96, j0 = (unit % 96) * 64, col = tid & 63, kq = tid >> 6;
    for (int i = tid; i < 8192; i += NTHR) { const float v = c[i]; sc[i] = v / (1.f + __expf(-v)); }
    __syncthreads();
    float acc[8] = {0.f, 0.f, 0.f, 0.f, 0.f, 0.f, 0.f, 0.f};
    const float* w = w_ada + (size_t)l * 1024 * 6144 + j0 + col;
    for (int k = kq * 128; k < kq * 128 + 128; k += 16) { float wv[16];
#pragma unroll
        for (int j = 0; j < 16; ++j) wv[j] = w[(size_t)(k + j) * 6144];
#pragma unroll
        for (int j = 0; j < 16; ++j)
#pragma unroll
            for (int b = 0; b < 8; ++b) acc[b] += sc[b * 1024 + k + j] * wv[j]; }
#pragma unroll
    for (int b = 0; b < 8; ++b) red[(kq * 8 + b) * 64 + col] = acc[b];
    __syncthreads();
    { const int b = kq; float s = b_ada[l * 6144 + j0 + col];
#pragma unroll
      for (int q = 0; q < 8; ++q) s += red[(q * 8 + b) * 64 + col];
      mod[((size_t)l * 8 + b) * 6144 + j0 + col] = s; }
    __syncthreads();
}
template <bool XF32, bool MOD, int NR>
__device__ __forceinline__ void norm_rows(const void* __restrict__ x0, const float* __restrict__ g, const float* __restrict__ sh, const float* __restrict__ sc, bf16_t* h0, float* f0, int lane) {
    const int c0 = lane * 16;
    float gm[16], shv[16];
#pragma unroll
    for (int j = 0; j < 4; ++j) { const float4 gv = *(const float4*)(g + c0 + 4 * j); gm[4 * j] = gv.x; gm[4 * j + 1] = gv.y; gm[4 * j + 2] = gv.z; gm[4 * j + 3] = gv.w;
        if (MOD) { const float4 s4 = *(const float4*)(sc + c0 + 4 * j), h4 = *(const float4*)(sh + c0 + 4 * j);
            gm[4 * j] *= 1.f + s4.x; gm[4 * j + 1] *= 1.f + s4.y; gm[4 * j + 2] *= 1.f + s4.z; gm[4 * j + 3] *= 1.f + s4.w; shv[4 * j] = h4.x; shv[4 * j + 1] = h4.y; shv[4 * j + 2] = h4.z; shv[4 * j + 3] = h4.w; } }
    float4 xf[XF32 ? NR : 1][4]; uint4 xh[XF32 ? 1 : NR][2];
#pragma unroll
    for (int r = 0; r < NR; ++r) {
        if (XF32) { const float4* xr = (const float4*)((const float*)x0 + (size_t)r * D) + lane * 4;
#pragma unroll
            for (int j = 0; j < 4; ++j) xf[r][j] = xr[j]; }
        else { const uint4* xr = (const uint4*)((const bf16_t*)x0 + (size_t)r * D) + lane * 2; xh[r][0] = xr[0]; xh[r][1] = xr[1]; } }
#pragma unroll
    for (int r = 0; r < NR; ++r) {
        float v[16];
        if (XF32) {
#pragma unroll
            for (int j = 0; j < 4; ++j) { v[4 * j] = xf[r][j].x; v[4 * j + 1] = xf[r][j].y; v[4 * j + 2] = xf[r][j].z; v[4 * j + 3] = xf[r][j].w; } }
        else {
#pragma unroll
            for (int j = 0; j < 2; ++j) { const uint4 t = xh[r][j];
                v[8 * j] = __uint_as_float(t.x << 16); v[8 * j + 1] = __uint_as_float(t.x & 0xffff0000u); v[8 * j + 2] = __uint_as_float(t.y << 16); v[8 * j + 3] = __uint_as_float(t.y & 0xffff0000u);
                v[8 * j + 4] = __uint_as_float(t.z << 16); v[8 * j + 5] = __uint_as_float(t.z & 0xffff0000u); v[8 * j + 6] = __uint_as_float(t.w << 16); v[8 * j + 7] = __uint_as_float(t.w & 0xffff0000u); } }
        float s = 0.f;
#pragma unroll
        for (int j = 0; j < 16; ++j) s += v[j] * v[j];
        const float rs = rsqrtf(wave_sum(s) * (1.f / D) + EPS);
        if (MOD) { uint4 w0, w1;
            w0.x = pk2(v[0] * rs * gm[0] + shv[0], v[1] * rs * gm[1] + shv[1]); w0.y = pk2(v[2] * rs * gm[2] + shv[2], v[3] * rs * gm[3] + shv[3]);
            w0.z = pk2(v[4] * rs * gm[4] + shv[4], v[5] * rs * gm[5] + shv[5]); w0.w = pk2(v[6] * rs * gm[6] + shv[6], v[7] * rs * gm[7] + shv[7]);
            w1.x = pk2(v[8] * rs * gm[8] + shv[8], v[9] * rs * gm[9] + shv[9]); w1.y = pk2(v[10] * rs * gm[10] + shv[10], v[11] * rs * gm[11] + shv[11]);
            w1.z = pk2(v[12] * rs * gm[12] + shv[12], v[13] * rs * gm[13] + shv[13]); w1.w = pk2(v[14] * rs * gm[14] + shv[14], v[15] * rs * gm[15] + shv[15]);
            uint4* hp = (uint4*)(h0 + (size_t)r * D + c0); hp[0] = w0; hp[1] = w1; }
        else { float4* fp = (float4*)(f0 + (size_t)r * D + c0);
#pragma unroll
            for (int j = 0; j < 4; ++j) fp[j] = make_float4(v[4 * j] * rs * gm[4 * j], v[4 * j + 1] * rs * gm[4 * j + 1], v[4 * j + 2] * rs * gm[4 * j + 2], v[4 * j + 3] * rs * gm[4 * j + 3]); }
    }
}
constexpr int POOL_UP = 528;
template <int HW>
__device__ __forceinline__ void pool_afr(const LAS unsigned char* base, const float inv, __attribute__((ext_vector_type(8))) short (&afr)[4]) {
    typedef unsigned ux4 __attribute__((ext_vector_type(4))); typedef __attribute__((ext_vector_type(8))) short bfx8;
#pragma unroll
    for (int ks = 0; ks < 4; ++ks) {
        float acc[8] = {0.f, 0.f, 0.f, 0.f, 0.f, 0.f, 0.f, 0.f};
#pragma unroll
        for (int o = -HW; o < HW; ++o) { const ux4 v = *(const LAS ux4*)(base + o * POOL_UP + ks * 32);
            acc[0] += __uint_as_float(v.x << 16); acc[1] += __uint_as_float(v.x & 0xffff0000u); acc[2] += __uint_as_float(v.y << 16); acc[3] += __uint_as_float(v.y & 0xffff0000u);
            acc[4] += __uint_as_float(v.z << 16); acc[5] += __uint_as_float(v.z & 0xffff0000u); acc[6] += __uint_as_float(v.w << 16); acc[7] += __uint_as_float(v.w & 0xffff0000u); }
        const ux4 c = *(const LAS ux4*)(base + ks * 32);
        ux4 w; w.x = pk2(acc[0] * inv - __uint_as_float(c.x << 16), acc[1] * inv - __uint_as_float(c.x & 0xffff0000u)); w.y = pk2(acc[2] * inv - __uint_as_float(c.y << 16), acc[3] * inv - __uint_as_float(c.y & 0xffff0000u));
        w.z = pk2(acc[4] * inv - __uint_as_float(c.z << 16), acc[5] * inv - __uint_as_float(c.z & 0xffff0000u)); w.w = pk2(acc[6] * inv - __uint_as_float(c.w << 16), acc[7] * inv - __uint_as_float(c.w & 0xffff0000u));
        afr[ks] = __builtin_bit_cast(bfx8, w);
    }
}
__device__ __forceinline__ void poolconv_rows(const bf16_t* __restrict__ proj, bf16_t* __restrict__ mix, const bf16_t* __restrict__ wpT, const float* __restrict__ pool_scale, const float* __restrict__ conv_w,
                                              int R0, LAS unsigned char* lds, int tid) {
    typedef __attribute__((ext_vector_type(8))) short bfx8; typedef __attribute__((ext_vector_type(16))) float fx16; typedef unsigned ux4 __attribute__((ext_vector_type(4)));
    constexpr int UP = POOL_UP;
    const int t0 = R0 % SEQ; const size_t rb = (size_t)(R0 - t0);
    const int lane = tid & 63, r32 = lane & 31, hi = lane >> 5, wid = __builtin_amdgcn_readfirstlane(tid >> 6);
    { ux4 v[9];
#pragma unroll
      for (int k = 0; k < 9; ++k) { const int i = tid + k * NTHR, r = i >> 5, c16 = i & 31, tt = t0 - 8 + r;
          v[k] = (ux4){0u, 0u, 0u, 0u}; if (tt >= 0 && tt < SEQ) v[k] = *(const ux4*)(proj + (rb + tt) * INW + O_P + c16 * 8); }
#pragma unroll
      for (int k = 0; k < 9; ++k) { const int i = tid + k * NTHR, r = i >> 5, c16 = i & 31; *(LAS ux4*)(lds + r * UP + c16 * 16) = v[k]; } }
    __syncthreads();
    const int blk = wid & 3;
#pragma unroll 1
    for (int task = 0; task < 2; ++task) {
        const int g = (wid >> 2) ? (task ? 2 : 1) : (task ? 3 : 0); const int hw = 1 << g;
        const int t = t0 + blk * 32 + r32; int lo = t - hw; if (lo < 0) lo = 0; int hi_ = t + hw; if (hi_ > SEQ) hi_ = SEQ;
        const float inv = 1.f / (float)(hi_ - lo);
        const LAS unsigned char* base = lds + (blk * 32 + r32 + 8) * UP + (g * 64 + hi * 8) * 2;
        bfx8 b0f[4], b1f[4];
#pragma unroll
        for (int ks = 0; ks < 4; ++ks) { b0f[ks] = *(const bfx8*)(wpT + (size_t)(g * 64 + r32) * 64 + ks * 16 + hi * 8); b1f[ks] = *(const bfx8*)(wpT + (size_t)(g * 64 + 32 + r32) * 64 + ks * 16 + hi * 8); }
        bfx8 afr[4];
        if (g == 0) pool_afr<1>(base, inv, afr); else if (g == 1) pool_afr<2>(base, inv, afr); else if (g == 2) pool_afr<4>(base, inv, afr); else pool_afr<8>(base, inv, afr);
        fx16 d0 = fx16{}, d1 = fx16{};
#pragma unroll
        for (int ks = 0; ks < 4; ++ks) {
            d0 = __builtin_amdgcn_mfma_f32_32x32x16_bf16(afr[ks], b0f[ks], d0, 0, 0, 0); d1 = __builtin_amdgcn_mfma_f32_32x32x16_bf16(afr[ks], b1f[ks], d1, 0, 0, 0);
        }
        const float ps0 = pool_scale[g * 64 + r32], ps1 = pool_scale[g * 64 + 32 + r32];
        bf16_t* op = mix + (size_t)(R0 + blk * 32) * D + 512 + g * 64 + r32;
#pragma unroll
        for (int r = 0; r < 16; ++r) { const int orow = (r & 3) + 8 * (r >> 2) + 4 * hi; op[(size_t)orow * D] = f2bf(d0[r] * ps0); op[(size_t)orow * D + 32] = f2bf(d1[r] * ps1); }
    }
    __syncthreads();
#pragma unroll 1
    for (int bt = 0; bt < 2; ++bt) {
        uint4 cb[4], cc[4], cx[4], cm[4], xm[4], cp[4], xp[4];
#pragma unroll
        for (int k = 0; k < 4; ++k) { const int i = tid + (bt * 4 + k) * NTHR, r = i >> 5, j0 = (i & 31) * 8, t = t0 + r; const bf16_t* pr = proj + (size_t)(R0 + r) * INW;
            const bf16_t* pm = t > 0 ? pr - INW : pr; const bf16_t* pp = t < SEQ - 1 ? pr + INW : pr;
            cb[k] = *(const uint4*)(pr + O_B + j0); cc[k] = *(const uint4*)(pr + O_C + j0); cx[k] = *(const uint4*)(pr + O_X + j0);
            cm[k] = *(const uint4*)(pm + O_C + j0); xm[k] = *(const uint4*)(pm + O_X + j0); cp[k] = *(const uint4*)(pp + O_C + j0); xp[k] = *(const uint4*)(pp + O_X + j0); }
#pragma unroll
        for (int k = 0; k < 4; ++k) { const int i = tid + (bt * 4 + k) * NTHR, r = i >> 5, j0 = (i & 31) * 8, t = t0 + r;
            const float mk_m = t > 0 ? 1.f : 0.f, mk_p = t < SEQ - 1 ? 1.f : 0.f;
            const bf16_t* pb = (const bf16_t*)&cb[k]; const bf16_t* pc = (const bf16_t*)&cc[k]; const bf16_t* px = (const bf16_t*)&cx[k];
            const bf16_t* pcm = (const bf16_t*)&cm[k]; const bf16_t* pxm = (const bf16_t*)&xm[k]; const bf16_t* pcp = (const bf16_t*)&cp[k]; const bf16_t* pxp = (const bf16_t*)&xp[k];
            float y[8];
#pragma unroll
            for (int e = 0; e < 8; ++e) { const int j = j0 + e;
                const float u0 = bf2f(pc[e]) * bf2f(px[e]), um = mk_m * (bf2f(pcm[e]) * bf2f(pxm[e])), up = mk_p * (bf2f(pcp[e]) * bf2f(pxp[e]));
                y[e] = bf2f(pb[e]) * (conv_w[j] * um + conv_w[256 + j] * u0 + conv_w[512 + j] * up); }
            uint4 o; o.x = pk2(y[0], y[1]); o.y = pk2(y[2], y[3]); o.z = pk2(y[4], y[5]); o.w = pk2(y[6], y[7]);
            *(uint4*)(mix + (size_t)(R0 + r) * D + 768 + j0) = o; } }
}

#define XB_TMO      128
#define XB_XCNT(j)  (256  + 64 * (j))
#define XB_XSUB(j)  (1280 + 64 * (j))
#define XB_XGEN(j)  (2304 + 64 * (j))
#define XB_TOP      3328
#define XB_TOPGEN   3392
#define XCD_BAR_WORDS 3456
#define XB_SPIN_CAP (1u << 18)

__device__ __forceinline__ unsigned xb_ld(unsigned* p)              { return __hip_atomic_load(p, __ATOMIC_RELAXED, __HIP_MEMORY_SCOPE_AGENT); }
__device__ __forceinline__ unsigned xb_add(unsigned* p, unsigned v) { return __hip_atomic_fetch_add(p, v, __ATOMIC_RELAXED, __HIP_MEMORY_SCOPE_AGENT); }
__device__ __forceinline__ unsigned xb_xcc_id() { return (unsigned)__builtin_amdgcn_s_getreg((3 << 11) | 20) & 0xFu; }
#define XB_SPIN(cond, bar) do { unsigned _sp = 0; while (cond) { __builtin_amdgcn_s_sleep(1); \
    if ((++_sp & 255u) == 0u) { if (xb_ld(&(bar)[XB_TMO])) break; if (_sp > XB_SPIN_CAP) { atomicAdd(&(bar)[XB_TMO], 1u); break; } } } } while (0)

struct XcdBarrier {
    unsigned* bar; unsigned x;
    volatile LAS unsigned* st;
};

__device__ __forceinline__ XcdBarrier xcd_barrier_post(unsigned* bar, volatile LAS unsigned* st) {
    XcdBarrier b; b.bar = bar; b.x = xb_xcc_id(); b.st = st;
    if (threadIdx.x == 0) (void)xb_add(&bar[XB_XCNT(b.x)], 1u);
    return b;
}
__device__ __forceinline__ void xcd_barrier_complete(unsigned* bar, unsigned x, unsigned& nloc, unsigned& nx) {
    const unsigned G = gridDim.x * gridDim.y * gridDim.z;
    unsigned sum, cnt, mine, sp = 0u;
    for (;;) {
        sum = 0u; cnt = 0u; mine = 0u;
#pragma unroll
        for (unsigned j = 0; j < 16; ++j) { const unsigned c = xb_ld(&bar[XB_XCNT(j)]); sum += c; cnt += (c > 0u) ? 1u : 0u; mine = (j == x) ? c : mine; }
        if (sum == G) break;
        __builtin_amdgcn_s_sleep(1);
        if ((++sp & 255u) == 0u) { if (xb_ld(&bar[XB_TMO])) break; if (sp > XB_SPIN_CAP) { atomicAdd(&bar[XB_TMO], 1u); break; } }
    }
    nloc = mine > 0u ? mine : 1u; nx = cnt > 0u ? cnt : 1u;
}

__device__ __forceinline__ void xcd_barrier(const XcdBarrier& b) {
    asm volatile("s_waitcnt vmcnt(0)" ::: "memory");
    __syncthreads();
    if (threadIdx.x == 0) {
        unsigned* bar = b.bar;
        __builtin_amdgcn_s_waitcnt(0);
        unsigned nloc = b.st[0], nx = b.st[1];
        if (nloc == 0u) { xcd_barrier_complete(bar, b.x, nloc, nx); b.st[0] = nloc; b.st[1] = nx; }
        const unsigned old = xb_add(&bar[XB_XSUB(b.x)], 1u);
        const unsigned gen = old / nloc;
        if (old + 1u == (gen + 1u) * nloc) {
            __builtin_amdgcn_fence(__ATOMIC_RELEASE, "agent");
            asm volatile("s_waitcnt vmcnt(0)" ::: "memory");
            const unsigned og = xb_add(&bar[XB_TOP], 1u);
            const unsigned tg = og / nx;
            if (og + 1u == (tg + 1u) * nx) xb_add(&bar[XB_TOPGEN], 1u);
            else XB_SPIN(xb_ld(&bar[XB_TOPGEN]) == tg, bar);
            __builtin_amdgcn_fence(__ATOMIC_ACQUIRE, "agent");
            xb_add(&bar[XB_XGEN(b.x)], 1u);
            asm volatile("s_waitcnt vmcnt(0)" ::: "memory");
        } else {
            XB_SPIN(xb_ld(&bar[XB_XGEN(b.x)]) == gen, bar);
            __builtin_amdgcn_fence(__ATOMIC_ACQUIRE, "agent");
            asm volatile("s_waitcnt vmcnt(0)" ::: "memory");
        }
    }
    __syncthreads();
}
#define XB_XSUB2(j) (12800 - 1024 + 64 * (j))
#define XB_XGEN2(j) (13824 - 1024 + 64 * (j))
#define XB_MISMAP   (14900 - 1024)
__device__ __forceinline__ void xcd_local_barrier(const XcdBarrier& b) {
    asm volatile("s_waitcnt vmcnt(0)" ::: "memory");
    __syncthreads();
    if (threadIdx.x == 0) {
        unsigned* bar = b.bar;
        __builtin_amdgcn_s_waitcnt(0);
        unsigned nloc = b.st[0], nx = b.st[1];
        if (nloc == 0u) { xcd_barrier_complete(bar, b.x, nloc, nx); b.st[0] = nloc; b.st[1] = nx; }
        const unsigned old = xb_add(&bar[XB_XSUB2(b.x)], 1u);
        const unsigned gen = old / nloc;
        if (old + 1u == (gen + 1u) * nloc) xb_add(&bar[XB_XGEN2(b.x)], 1u);
        else XB_SPIN(xb_ld(&bar[XB_XGEN2(b.x)]) == gen, bar);
        __builtin_amdgcn_fence(__ATOMIC_ACQUIRE, "agent");
        asm volatile("s_waitcnt vmcnt(0)" ::: "memory");
    }
    __syncthreads();
}
constexpr int N_PHASES = 16;
#ifndef ATT_SKIP_T
#define ATT_SKIP_T 36
#endif
struct Args { const float* in[19]; float* out; unsigned char* ws; int ph_lo, ph_hi, li, pad; };
__device__ __forceinline__ const float* arg_in(int k) { const int o = launder_s(k * 8); return *(const float* const*)((const char*)__builtin_amdgcn_kernarg_segment_ptr() + o); }
__device__ __forceinline__ unsigned char* arg_ws() { const int o = launder_s(160); return *(unsigned char* const*)((const char*)__builtin_amdgcn_kernarg_segment_ptr() + o); }
__device__ __forceinline__ float* arg_out() { const int o = launder_s(152); return *(float* const*)((const char*)__builtin_amdgcn_kernarg_segment_ptr() + o); }
__global__ void __launch_bounds__(NTHR, 2) mk_fwd(Args a) {
    extern __shared__ __attribute__((aligned(16))) unsigned char lds[];
    cg::grid_group grid = cg::this_grid();
    const int tid = threadIdx.x, wave = __builtin_amdgcn_readfirstlane(tid >> 6);
#define lane (launder_v(tid) & 63)
    const int G = gridDim.x, bx = blockIdx.x; const int vcu = (G % 8 == 0) ? (bx % 8) * (G / 8) + bx / 8 : bx;
    const int gw = vcu * NWAVES + wave, ngw = G * NWAVES;
    __builtin_assume(gw >= 0 && gw < 4096 && ngw > 0);
    LAS unsigned char* ldsl = (LAS unsigned char*)lds;
#define ws (arg_ws())
#define x (arg_in(0))
#define out (arg_out())
#define mod ((float*)(ws + WS_MOD))
#define win_t ((bf16_t*)(ws + WS_WIN))
#define wout_t ((bf16_t*)(ws + WS_WOUT))
#define wgu_t ((bf16_t*)(ws + WS_WGU))
#define wdn_t ((bf16_t*)(ws + WS_WDN))
#define xb ((bf16_t*)(ws + WS_XB))
#define hb ((bf16_t*)(ws + WS_H))
#define mix ((bf16_t*)(ws + WS_MIX))
#define proj ((bf16_t*)(ws + WS_PROJ))
#define act ((bf16_t*)(ws + WS_ACT))
    const int lo = a.ph_lo, hi = a.ph_hi;
    const bool fuse = G == 256 && lo == 0 && hi == N_PHASES;
#define NORM_PART(k) ((float*)(ws + WS_PART) + (size_t)(k) * 131072)
#define NORM_CNT(k) ((unsigned*)(ws + WS_CTL) + 4608 + (k) * 2048)
#define NORM_LS ((LAS float*)(ldsl + MISC_OFF + 1024))
    for (int u = tid; u < (LDS_BYTES - MISC_OFF) / 4; u += NTHR) ((LAS unsigned*)(ldsl + MISC_OFF))[u] = 0u;
    __syncthreads();
    XcdBarrier bar = xcd_barrier_post((unsigned*)(ws + WS_CTL) + 1024 + a.li * XCD_BAR_WORDS, (volatile LAS unsigned*)(ldsl + MISC_OFF) + 8);
    if (tid == 0) (void)__hip_atomic_fetch_or(bar.bar + XB_MISMAP + (bx & 7), 1u << xb_xcc_id(), __ATOMIC_RELAXED, __HIP_MEMORY_SCOPE_AGENT);
#define IN(k) (lo <= (k) && (k) < hi)
#define INL(j) (lo <= (pb + (j)) && (pb + (j)) < hi)
#define SEAML(j) do { if (lo <= (pb + (j)) && (pb + (j)) + 1 < hi) { if (localok) xcd_local_barrier(bar); else xcd_barrier(bar); } } while (0)
#define SEAM(k) do { if (lo <= (k) && (k) + 1 < hi) grid.sync(); } while (0)

    if (IN(0)) {
        LAS float* scr = (LAS float*)(ldsl + wave * 16640);
        int cursor = 0;
        for (int l = 0; l < DEPTH; ++l) {
            p0_transpose_matrix(arg_in(5) + (size_t)l * D * INW, D, INW, win_t + (size_t)l * INW * D, false, scr, gw, ngw, lane, cursor);
            p0_transpose_matrix(arg_in(14) + (size_t)l * D * D, D, D, wout_t + (size_t)l * D * D, false, scr, gw, ngw, lane, cursor);
            p0_transpose_matrix(arg_in(16) + (size_t)l * D * NGU, D, NGU, wgu_t + (size_t)l * NGU * D, true, scr, gw, ngw, lane, cursor);
            p0_transpose_matrix(arg_in(17) + (size_t)l * DFF * D, DFF, D, wdn_t + (size_t)l * D * DFF, false, scr, gw, ngw, lane, cursor);
        }
        { bf16_t* wpT = (bf16_t*)(ws + WS_WPT);
          for (int i = gw * 64 + lane; i < DEPTH * 4 * 4096; i += ngw * 64) { const int lg = i >> 12, d = (i >> 6) & 63, c = i & 63; wpT[i] = f2bf(arg_in(11)[(size_t)lg * 4096 + c * 64 + d]); } }
        __syncthreads();
        for (int u = bx; u < 192; u += G) p0_mod_unit(arg_in(1), arg_in(2), arg_in(3), mod, u, (LAS float*)ldsl, tid);
    }
    SEAM(0);
    bool localok = fuse;
    for (int g8 = 0; g8 < 8; ++g8) { const unsigned mk = (unsigned)__builtin_amdgcn_readfirstlane((int)xb_ld((unsigned*)(ws + WS_CTL) + 1024 + XB_MISMAP + g8)); localok = localok && mk != 0u && (mk & (mk - 1u)) == 0u; }

    for (int l = 0; l < DEPTH; ++l) {
        const int pb = launder_s(1 + 7 * l);
        const float* modl = mod + (size_t)l * 8 * 6144;
        if (INL(0) && !(fuse && l > 0)) {
            const int m_lo = fuse ? (bx & 7) * SEQ + ((bx >> 3) * NWAVES + wave) * 16 : gw * 4, m_hi = fuse ? m_lo + 16 : M, m_st = fuse ? 4 : ngw * 4;
            for (int m = m_lo; m < m_hi; m += m_st) { const float* mb = modl + (size_t)(m / SEQ) * 6144;
                if (l == 0) norm_rows<true, true, 4>(x + (size_t)m * D, arg_in(4) + l * D, mb + 0, mb + 1024, hb + (size_t)m * D, nullptr, lane);
                else norm_rows<false, true, 4>(xb + (size_t)m * D, arg_in(4) + l * D, mb + 0, mb + 1024, hb + (size_t)m * D, nullptr, lane); }
        }
        if (!(fuse && l > 0)) SEAML(0);
        if (INL(1)) {
            pg8::Gemm g{hb, win_t + (size_t)l * INW * D, M, INW, D}; pg8::StaticOrder S; S.init(M, INW, G, bx);
            pg8::EpiProj E{proj, INW, C2, (unsigned*)(ws + WS_KN2) + l * 8192, BPAD};
            pg8::gemm_phase<pg8::EpiProj, pg8::StaticOrder, true, true>(ldsl, g, S, E);
        }
        SEAML(1);
        if (INL(2)) {
            const float lambda_init = l == 0 ? 0.2f : 0.35550906759096926f;
            float d1 = 0.f, d2 = 0.f;
            for (int i = 0; i < 32; ++i) { d1 += arg_in(6)[l * 32 + i] * arg_in(7)[l * 32 + i]; d2 += arg_in(8)[l * 32 + i] * arg_in(9)[l * 32 + i]; }
            const float lam = __expf(d1) - __expf(d2) + lambda_init;
            const unsigned* kn2 = (const unsigned*)(ws + WS_KN2) + l * 8192;
            {
                const bool useq = G == 256; const int xg = bx & 7;
                unsigned* qcnt = (unsigned*)(ws + WS_CTL) + 15000 + (l * 8 + xg) * 64;
                volatile LAS unsigned* qw = (volatile LAS unsigned*)(ldsl + MISC_OFF) + 16;
                if (useq) { if (tid == 0) qw[0] = __hip_atomic_fetch_add(qcnt, 1u, __ATOMIC_RELAXED, __HIP_MEMORY_SCOPE_AGENT); __syncthreads(); }
                int sidx = bx;
                for (int it = 0;; ++it) {
                    int idx, bsel; unsigned nxt = 0u;
                    if (useq) { idx = (int)qw[it & 1]; if (idx >= 160) break; bsel = xg; if (tid == 0) nxt = __hip_atomic_fetch_add(qcnt, 1u, __ATOMIC_RELAXED, __HIP_MEMORY_SCOPE_AGENT); }
                    else { if (sidx >= BATCH * 160) break; bsel = sidx / 160; idx = sidx % 160; sidx += G; }
                    const int cls = idx >> 4, e = idx & 15;
                    if (cls >= 8) {
                        const int r = bsel * 32 + (idx - 128);
                        poolconv_rows(proj + (size_t)bsel * BPAD, mix, (const bf16_t*)(ws + WS_WPT) + (size_t)l * 4 * 4096, arg_in(12) + l * 256, arg_in(13) + l * 768, r * 128, ldsl, launder_v(tid));
                    } else {
                        const int hsel = 7 - cls;
                        const int qb = (e & 1) ? 8 + (e >> 1) : 7 - (e >> 1);
                        att::attn_unit<20, ATT_SKIP_T>(bsel, hsel, qb, proj + (size_t)bsel * BPAD, mix, arg_in(10) + l * 512 + hsel * 64, lam, 1.f - lambda_init, kn2, (char*)lds);
                    }
                    if (useq && tid == 0) qw[(it + 1) & 1] = nxt;
                    __syncthreads();
                }
            }
        }
        SEAML(2);
        if (INL(3)) {
            pg8::Gemm g{mix, wout_t + (size_t)l * D * D, M, D, D}; pg8::StaticOrder S; S.init(M, D, G, bx);
            if (fuse) {
                if (l == 0) { pg8::EpiResidNorm<true, false> E{x, xb, D, modl + 2048, SEQ, arg_in(15) + l * D, modl + 3072, modl + 4096, hb, nullptr, NORM_PART(2 * l), NORM_CNT(2 * l), NORM_LS}; pg8::gemm_phase<pg8::EpiResidNorm<true, false>, pg8::StaticOrder, true, true>(ldsl, g, S, E); }
                else { pg8::EpiResidNorm<false, false> E{xb, xb, D, modl + 2048, SEQ, arg_in(15) + l * D, modl + 3072, modl + 4096, hb, nullptr, NORM_PART(2 * l), NORM_CNT(2 * l), NORM_LS}; pg8::gemm_phase<pg8::EpiResidNorm<false, false>, pg8::StaticOrder, true, true>(ldsl, g, S, E); }
            } else {
            if (l == 0) { pg8::EpiResid<true> E{x, xb, D, modl + 2048, SEQ}; pg8::gemm_phase<pg8::EpiResid<true>, pg8::StaticOrder, true, true>(ldsl, g, S, E); }
            else { pg8::EpiResid<false> E{xb, xb, D, modl + 2048, SEQ}; pg8::gemm_phase<pg8::EpiResid<false>, pg8::StaticOrder, true, true>(ldsl, g, S, E); }
            }
        }
        if (!fuse) SEAML(3);
        if (INL(4) && !fuse) {
            for (int m = gw * 4; m < M; m += ngw * 4) { const float* mb = modl + (size_t)(m / SEQ) * 6144;
                norm_rows<false, true, 4>(xb + (size_t)m * D, arg_in(15) + l * D, mb + 3072, mb + 4096, hb + (size_t)m * D, nullptr, lane); }
        }
        SEAML(4);
        if (INL(5)) {
            pg8::Gemm g{hb, wgu_t + (size_t)l * NGU * D, M, NGU, D}; pg8::StaticOrder S; S.init(M, NGU, G, bx);
            pg8::EpiSwiglu E{act, DFF};
            pg8::gemm_phase<pg8::EpiSwiglu, pg8::StaticOrder, true, true>(ldsl, g, S, E);
        }
        SEAML(5);
        if (INL(6)) {
            pg8::Gemm g{act, wdn_t + (size_t)l * D * DFF, M, D, DFF}; pg8::StaticOrder S; S.init(M, D, G, bx);
            if (fuse) {
                if (l + 1 < DEPTH) { const float* modn = mod + (size_t)(l + 1) * 8 * 6144;
                    pg8::EpiResidNorm<false, false> E{xb, xb, D, modl + 5120, SEQ, arg_in(4) + (l + 1) * D, modn + 0, modn + 1024, hb, nullptr, NORM_PART(2 * l + 1), NORM_CNT(2 * l + 1), NORM_LS}; pg8::gemm_phase<pg8::EpiResidNorm<false, false>, pg8::StaticOrder, true, true>(ldsl, g, S, E); }
                else { pg8::EpiResidNorm<false, true> E{xb, xb, D, modl + 5120, SEQ, arg_in(18), nullptr, nullptr, nullptr, out, NORM_PART(2 * l + 1), NORM_CNT(2 * l + 1), NORM_LS}; pg8::gemm_phase<pg8::EpiResidNorm<false, true>, pg8::StaticOrder, true, true>(ldsl, g, S, E); }
            } else {
            pg8::EpiResid<false> E{xb, xb, D, modl + 5120, SEQ};
            pg8::gemm_phase<pg8::EpiResid<false>, pg8::StaticOrder, true, true>(ldsl, g, S, E);
            }
        }
        if (!(fuse && l + 1 == DEPTH)) SEAML(6);
    }
    if (IN(15) && !fuse) {
        for (int m = gw * 4; m < M; m += ngw * 4) norm_rows<false, false, 4>(xb + (size_t)m * D, arg_in(18), nullptr, nullptr, nullptr, out + (size_t)m * D, lane);
    }
#undef lane
#undef ws
#undef x
#undef out
#undef mod
#undef win_t
#undef wout_t
#undef wgu_t
#undef wdn_t
#undef xb
#undef hb
#undef mix
#undef proj
#undef act
#undef IN
#undef INL
#undef SEAM
#undef SEAML
#undef NORM_PART
#undef NORM_CNT
#undef NORM_LS
}

extern "C" void kernel_launch(void* const* d_in, const int* in_sizes, int n_in, void* d_out, int out_size, void* d_ws, size_t ws_size, hipStream_t stream) {
    static int grid = 0;
    if (grid == 0) {
        if (n_in != 19 || in_sizes[0] != M * D || out_size != M * D || ws_size < WS_END) { fprintf(stderr, "kernel_launch: unexpected shapes / workspace (n_in %d, ws %zu); nothing launched\n", n_in, ws_size); grid = -1; return; }
        int dev = 0, cus = 0, per_cu = 0;
        if (hipGetDevice(&dev) != hipSuccess || hipDeviceGetAttribute(&cus, hipDeviceAttributeMultiprocessorCount, dev) != hipSuccess) { grid = -1; return; }
        if (hipFuncSetAttribute((const void*)mk_fwd, hipFuncAttributeMaxDynamicSharedMemorySize, LDS_BYTES) != hipSuccess) { fprintf(stderr, "kernel_launch: hipFuncSetAttribute failed\n"); grid = -1; return; }
        if (hipOccupancyMaxActiveBlocksPerMultiprocessor(&per_cu, (const void*)mk_fwd, NTHR, LDS_BYTES) != hipSuccess || per_cu < 1) { fprintf(stderr, "kernel_launch: occupancy query says %d blocks per CU\n", per_cu); (void)hipGetLastError(); grid = -1; return; }
        grid = cus;
    }
    if (grid < 0) return;
    (void)hipMemsetAsync((char*)d_ws + WS_CTL, 0, CTL_ZERO_BYTES, stream);
    Args a{};
    for (int i = 0; i < 19; ++i) a.in[i] = (const float*)d_in[i];
    a.out = (float*)d_out; a.ws = (unsigned char*)d_ws;
    a.ph_lo = 0; a.ph_hi = N_PHASES; a.li = 0;
    void* args[] = {&a};
    const hipError_t le = hipLaunchCooperativeKernel((const void*)mk_fwd, dim3(grid), dim3(NTHR), args, LDS_BYTES, stream);
    if (le != hipSuccess) fprintf(stderr, "kernel_launch: cooperative launch failed: %s (grid %d)\n", hipGetErrorString(le), grid);
}
```

```cpp
#include <hip/hip_runtime.h>
#include <hip/hip_cooperative_groups.h>
#include <cstdio>
#include <cstdint>
namespace cg = cooperative_groups;

typedef unsigned short bf16_t;
constexpr int BATCH = 8, SEQ = 4096, D = 1024, M = BATCH * SEQ, DEPTH = 2;
constexpr int INW = 2560, DFF = 2816, NGU = 2 * DFF;
constexpr int O_Q = 0, O_K = 512, O_V = 1024, O_P = 1536, O_B = 1792, O_C = 2048, O_X = 2304;
constexpr float EPS = 1e-6f;
constexpr float LOG2E = 1.4426950408889634f;
constexpr float C2 = 0.17677669529663687f * 1.4426950408889634f;

__device__ __forceinline__ float bf2f(bf16_t v) { return __uint_as_float(((unsigned)v) << 16); }
__device__ __forceinline__ bf16_t f2bf(float f) { unsigned u = __float_as_uint(f); return (bf16_t)((u + 0x7fffu + ((u >> 16) & 1u)) >> 16); }
__device__ __forceinline__ unsigned pk2(float lo, float hi) { return (unsigned)f2bf(lo) | ((unsigned)f2bf(hi) << 16); }

constexpr size_t MiB = 1u << 20;
constexpr size_t WS_CTL = 0, CTL_ZERO_BYTES = 128 * 1024;
constexpr size_t WS_KN2 = 64 * 1024;
constexpr size_t WS_MOD = 1 * MiB;
constexpr size_t WS_WIN = 2 * MiB;
constexpr size_t WS_WOUT = 12 * MiB;
constexpr size_t WS_WGU = 16 * MiB;
constexpr size_t WS_WDN = 38 * MiB;
constexpr size_t WS_WPT = 49 * MiB;
constexpr size_t WS_H = 50 * MiB;
constexpr size_t WS_MIX = 114 * MiB;
constexpr size_t BPAD = (size_t)SEQ * (DFF - INW);
constexpr size_t WS_PROJ = 178 * MiB;
constexpr size_t WS_ACT = 178 * MiB;
constexpr size_t WS_XB = 354 * MiB;
constexpr size_t WS_PART = 418 * MiB;
constexpr size_t WS_END = 420 * MiB;

__device__ __forceinline__ int launder_v(int v) { asm volatile("" : "+v"(v)); return v; }
__device__ __forceinline__ int launder_s(int v) { asm volatile("" : "+s"(v)); return v; }
#define GAS __attribute__((address_space(1)))
#define LAS __attribute__((address_space(3)))
typedef GAS unsigned gu32;
#define RLX_AGENT __ATOMIC_RELAXED, __HIP_MEMORY_SCOPE_AGENT
#define LDS_WAIT() asm volatile("s_waitcnt lgkmcnt(0)" ::: "memory")
#define VM_WAIT() asm volatile("s_waitcnt vmcnt(0)" ::: "memory")

namespace pg8 {
#define PG8_LAS __attribute__((address_space(3)))
typedef unsigned short bf16_t;
typedef short bf16x8 __attribute__((ext_vector_type(8)));
typedef float f32x4 __attribute__((ext_vector_type(4)));
typedef unsigned u32x4 __attribute__((ext_vector_type(4)));
constexpr int BM = 256, BK = 64, HALF = 128, HTB = HALF * BK * 2  , STAGE_BYTES = 8 * HTB, NXCD = 8, WGM = 4;

__host__ __device__ __forceinline__ int lds_byte(int r, int c) { const int st = (r >> 4) * 2 + (c >> 5), rr = r & 15, cc = c & 31, ob = rr * 64 + cc * 2; return st * 1024 + (ob ^ (((ob >> 9) & 1) << 5)); }
__host__ __device__ __forceinline__ void stage_rc(int b, int& R, int& C) { const int st = b / 1024, sb = b % 1024, swz = sb ^ (((sb >> 9) & 1) << 5); R = (st >> 1) * 16 + swz / 64; C = (st & 1) * 32 + (swz % 64) / 2; }
__host__ __device__ __forceinline__ int perm32(int rho) { const int n = rho >> 4, i = rho & 15; return 8 * (i >> 2) + 4 * n + (i & 3); }

struct Unit { int pm, pn; };
struct Gemm { const bf16_t* A; const bf16_t* Bt; int M, N, K; };

struct StaticOrder {
    int nM, nN, nwg, G, c;
    __host__ __device__ void init(int M, int N, int G_, int c_) { nM = M / BM; nN = N / BM; nwg = nM * nN; G = G_; c = c_; }
    __host__ __device__ bool next(int i, Unit& u) const {
        const long L = (long)i * G + c; if (L >= nwg) return false;
        int wgid = (int)L; { const int q = nwg / NXCD, r = nwg % NXCD, xcd = wgid % NXCD, off = wgid / NXCD; wgid = (xcd < r ? xcd * (q + 1) : r * (q + 1) + (xcd - r) * q) + off; }
        const int nig = WGM * nN, gid = wgid / nig, fm = gid * WGM, gsz = (nM - fm) < WGM ? (nM - fm) : WGM;
        u.pm = fm + ((wgid % nig) % gsz); u.pn = (wgid % nig) / gsz; return true;
    }
    __device__ __forceinline__ void a_ready(const Unit&) const {}
    __device__ __forceinline__ void done(const Unit&) const {}
};

__device__ __forceinline__ unsigned cvt_pk_bf16(float lo, float hi) { unsigned r; asm volatile("v_cvt_pk_bf16_f32 %0, %1, %2" : "=v"(r) : "v"(lo), "v"(hi)); return r; }
typedef float f32x2 __attribute__((ext_vector_type(2)));
struct EpiProj {
    static constexpr bool PERM = true, AFTER_DRAIN = false;
    bf16_t* O; int ldc; float qscale; unsigned* kn2; size_t bpad;
    __device__ __forceinline__ void operator()(const f32x4 (&acc)[2][2][4][2], const Unit& u, int wr, int wc, int fr, int fq) const {
        const int row0 = u.pm * BM + wr * 64 + fr, col0 = u.pn * BM + wc * 32 + 8 * fq;
        const float sc = u.pn < 2 ? qscale : 1.f;
#pragma unroll
        for (int ai = 0; ai < 2; ++ai)
#pragma unroll
            for (int m = 0; m < 4; ++m) { bf16_t* rowp = O + (size_t)(u.pm >> 4) * bpad + (size_t)(row0 + ai * HALF + m * 16) * ldc + col0;
#pragma unroll
                for (int bj = 0; bj < 2; ++bj) { const f32x4 v0 = acc[ai][bj][m][0] * sc, v1 = acc[ai][bj][m][1] * sc;
                    u32x4 w; w.x = cvt_pk_bf16(v0[0], v0[1]); w.y = cvt_pk_bf16(v0[2], v0[3]); w.z = cvt_pk_bf16(v1[0], v1[1]); w.w = cvt_pk_bf16(v1[2], v1[3]);
                    *(u32x4*)(rowp + bj * HALF) = w; } }
        if (u.pn == 2 || u.pn == 3) {
#pragma unroll
            for (int ai = 0; ai < 2; ++ai)
#pragma unroll
                for (int bj = 0; bj < 2; ++bj) { float mx = 0.f;
#pragma unroll
                    for (int m = 0; m < 4; ++m) { const f32x4 a = acc[ai][bj][m][0], b = acc[ai][bj][m][1];
                        float ss = (a[0] * a[0] + a[1] * a[1]) + (a[2] * a[2] + a[3] * a[3]) + (b[0] * b[0] + b[1] * b[1]) + (b[2] * b[2] + b[3] * b[3]);
                        ss += __shfl_xor(ss, 16); ss += __shfl_xor(ss, 32); mx = fmaxf(mx, ss); }
                    mx = fmaxf(mx, __shfl_xor(mx, 1)); mx = fmaxf(mx, __shfl_xor(mx, 2)); mx = fmaxf(mx, __shfl_xor(mx, 4)); mx = fmaxf(mx, __shfl_xor(mx, 8));
                    if (fr == 0 && fq == 0) { const int b = u.pm >> 4, tile = (u.pm * 4 + ai * 2 + wr) & 63, head = (u.pn - 2) * 4 + bj * 2 + (wc >> 1), half = wc & 1;
                        atomicMax(kn2 + ((b * 8 + head) * 2 + half) * 64 + tile, __float_as_uint(mx)); } }
        }
    }
};
__device__ __forceinline__ float silu_mul(float g, float u) { return g * u * __builtin_amdgcn_rcpf(1.f + __builtin_amdgcn_exp2f(-1.4426950408889634f * g)); }
struct EpiSwiglu {
    static constexpr bool PERM = true, AFTER_DRAIN = false;
    bf16_t* O; int ldc;
    __device__ __forceinline__ void operator()(const f32x4 (&acc)[2][2][4][2], const Unit& u, int wr, int wc, int fr, int fq) const {
        const int row0 = u.pm * BM + wr * 64 + fr, col0 = u.pn * HALF + wc * 32 + 8 * fq;
#pragma unroll
        for (int ai = 0; ai < 2; ++ai)
#pragma unroll
            for (int m = 0; m < 4; ++m) { bf16_t* rowp = O + (size_t)(row0 + ai * HALF + m * 16) * ldc + col0;
                const f32x4 g0 = acc[ai][0][m][0], g1 = acc[ai][0][m][1], u0 = acc[ai][1][m][0], u1 = acc[ai][1][m][1];
                u32x4 w; w.x = cvt_pk_bf16(silu_mul(g0[0], u0[0]), silu_mul(g0[1], u0[1])); w.y = cvt_pk_bf16(silu_mul(g0[2], u0[2]), silu_mul(g0[3], u0[3]));
                w.z = cvt_pk_bf16(silu_mul(g1[0], u1[0]), silu_mul(g1[1], u1[1])); w.w = cvt_pk_bf16(silu_mul(g1[2], u1[2]), silu_mul(g1[3], u1[3]));
                *(u32x4*)rowp = w; }
    }
};
template <bool BASE_F32>
struct EpiResid {
    static constexpr bool PERM = true, AFTER_DRAIN = false;
    const void* base; bf16_t* out; int ldc; const float* gt; int rows_per_batch;
    __device__ __forceinline__ void operator()(const f32x4 (&acc)[2][2][4][2], const Unit& u, int wr, int wc, int fr, int fq) const {
        const int col0 = u.pn * BM + wc * 32 + 8 * fq; const int b = (u.pm * BM) / rows_per_batch;
        f32x4 gv[2][2];
#pragma unroll
        for (int bj = 0; bj < 2; ++bj)
#pragma unroll
            for (int n = 0; n < 2; ++n) gv[bj][n] = *(const f32x4*)(gt + (size_t)b * 6144 + col0 + bj * HALF + 4 * n);
#pragma unroll
        for (int ai = 0; ai < 2; ++ai) {
            u32x4 wb[4][2]; f32x4 wf[BASE_F32 ? 4 : 1][2][2];
#pragma unroll
            for (int m = 0; m < 4; ++m) { const size_t off = (size_t)(u.pm * BM + ai * HALF + wr * 64 + m * 16 + fr) * ldc + col0;
#pragma unroll
                for (int bj = 0; bj < 2; ++bj) {
                    if (BASE_F32) { wf[m][bj][0] = *(const f32x4*)((const float*)base + off + bj * HALF); wf[m][bj][1] = *(const f32x4*)((const float*)base + off + bj * HALF + 4); }
                    else wb[m][bj] = *(const u32x4*)((const bf16_t*)base + off + bj * HALF); } }
#pragma unroll
            for (int m = 0; m < 4; ++m) { const size_t off = (size_t)(u.pm * BM + ai * HALF + wr * 64 + m * 16 + fr) * ldc + col0;
#pragma unroll
                for (int bj = 0; bj < 2; ++bj) { f32x4 b0, b1;
                    if (BASE_F32) { b0 = wf[m][bj][0]; b1 = wf[m][bj][1]; }
                    else { const u32x4 w = wb[m][bj];
                        b0 = (f32x4){__uint_as_float(w.x << 16), __uint_as_float(w.x & 0xffff0000u), __uint_as_float(w.y << 16), __uint_as_float(w.y & 0xffff0000u)};
                        b1 = (f32x4){__uint_as_float(w.z << 16), __uint_as_float(w.z & 0xffff0000u), __uint_as_float(w.w << 16), __uint_as_float(w.w & 0xffff0000u)}; }
                    const f32x4 x0 = b0 + gv[bj][0] * acc[ai][bj][m][0], x1 = b1 + gv[bj][1] * acc[ai][bj][m][1];
                    u32x4 o; o.x = cvt_pk_bf16(x0[0], x0[1]); o.y = cvt_pk_bf16(x0[2], x0[3]); o.z = cvt_pk_bf16(x1[0], x1[1]); o.w = cvt_pk_bf16(x1[2], x1[3]);
                    *(u32x4*)(out + off + bj * HALF) = o; } }
        }
    }
};
template <bool BASE_F32, bool FINAL>
struct EpiResidNorm {
    static constexpr bool PERM = true, AFTER_DRAIN = false;
    const void* base; bf16_t* xout; int ldc; const float* gt; int rows_per_batch;
    const float* g; const float* sh; const float* sc; bf16_t* h; float* fout;
    float* part; unsigned* cnt; PG8_LAS float* ls;
    __device__ __forceinline__ void operator()(const f32x4 (&acc)[2][2][4][2], const Unit& u, int wr, int wc, int fr, int fq) const {
#define PG8_LBAR() asm volatile("s_waitcnt lgkmcnt(0)\n\ts_barrier" ::: "memory")
        const int tid = launder_v((int)threadIdx.x);
        const int col0 = u.pn * BM + wc * 32 + 8 * fq; const int b = (u.pm * BM) / rows_per_batch;
        const int lrow = launder_v(wr * 64 + fr);
        f32x4 xv[2][2][4][2]; float ss[2][4];
        { f32x4 gv[2][2];
#pragma unroll
          for (int bj = 0; bj < 2; ++bj)
#pragma unroll
            for (int n = 0; n < 2; ++n) gv[bj][n] = *(const f32x4*)(gt + (size_t)b * 6144 + col0 + bj * HALF + 4 * n);
#pragma unroll
          for (int ai = 0; ai < 2; ++ai) {
            constexpr int MB = BASE_F32 ? 2 : 4;
#pragma unroll
            for (int m0 = 0; m0 < 4; m0 += MB) {
            u32x4 wb[MB][2]; f32x4 wf[MB][2][2];
#pragma unroll
            for (int mm = 0; mm < MB; ++mm) { const int m = m0 + mm; const size_t off = (size_t)(u.pm * BM + ai * HALF + wr * 64 + m * 16 + fr) * ldc + col0;
#pragma unroll
                for (int bj = 0; bj < 2; ++bj) {
                    if (BASE_F32) { wf[mm][bj][0] = *(const f32x4*)((const float*)base + off + bj * HALF); wf[mm][bj][1] = *(const f32x4*)((const float*)base + off + bj * HALF + 4); }
                    else wb[mm][bj] = *(const u32x4*)((const bf16_t*)base + off + bj * HALF); } }
#pragma unroll
            for (int mm = 0; mm < MB; ++mm) { const int m = m0 + mm; float s = 0.f;
#pragma unroll
                for (int bj = 0; bj < 2; ++bj) { f32x4 b0, b1;
                    if (BASE_F32) { b0 = wf[mm][bj][0]; b1 = wf[mm][bj][1]; }
                    else { const u32x4 w = wb[mm][bj];
                        b0 = (f32x4){__uint_as_float(w.x << 16), __uint_as_float(w.x & 0xffff0000u), __uint_as_float(w.y << 16), __uint_as_float(w.y & 0xffff0000u)};
                        b1 = (f32x4){__uint_as_float(w.z << 16), __uint_as_float(w.z & 0xffff0000u), __uint_as_float(w.w << 16), __uint_as_float(w.w & 0xffff0000u)}; }
                    const f32x4 x0 = b0 + gv[bj][0] * acc[ai][bj][m][0], x1 = b1 + gv[bj][1] * acc[ai][bj][m][1];
                    xv[ai][bj][m][0] = x0; xv[ai][bj][m][1] = x1;
                    s += (x0[0] * x0[0] + x0[1] * x0[1]) + (x0[2] * x0[2] + x0[3] * x0[3]) + (x1[0] * x1[0] + x1[1] * x1[1]) + (x1[2] * x1[2] + x1[3] * x1[3]); }
                s += __shfl_xor(s, 16); s += __shfl_xor(s, 32); ss[ai][m] = s; } } } }
        const int wid = tid >> 6, ln = tid & 63;
        if (fq == 0) {
#pragma unroll
            for (int ai = 0; ai < 2; ++ai)
#pragma unroll
                for (int m = 0; m < 4; ++m) ls[(ai * HALF + m * 16 + lrow) * 4 + wc] = ss[ai][m]; }
        PG8_LBAR();
        const int row = wid * 32 + (ln & 31);
        if (ln < 32) { const f32x4 p4 = *(const PG8_LAS f32x4*)(ls + row * 4);
            __hip_atomic_store(part + ((size_t)u.pm * 256 + row) * 4 + u.pn, (p4[0] + p4[1]) + (p4[2] + p4[3]), __ATOMIC_RELAXED, __HIP_MEMORY_SCOPE_AGENT); }
        asm volatile("s_waitcnt vmcnt(0)" ::: "memory");
        if (ln == 0) __hip_atomic_fetch_add(cnt + 16 * u.pm, 1u, __ATOMIC_RELAXED, __HIP_MEMORY_SCOPE_AGENT);
        if (!FINAL) {
#pragma unroll
            for (int bj = 0; bj < 2; ++bj)
#pragma unroll
                for (int ai = 0; ai < 2; ++ai)
#pragma unroll
                    for (int m = 0; m < 4; ++m) { const size_t off = (size_t)(u.pm * BM + ai * HALF + wr * 64 + m * 16 + fr) * ldc + col0 + bj * HALF;
                        const f32x4 x0 = xv[ai][bj][m][0], x1 = xv[ai][bj][m][1];
                        u32x4 o; o.x = cvt_pk_bf16(x0[0], x0[1]); o.y = cvt_pk_bf16(x0[2], x0[3]); o.z = cvt_pk_bf16(x1[0], x1[1]); o.w = cvt_pk_bf16(x1[2], x1[3]);
                        *(u32x4*)(xout + off) = o; } }
        if (wid == 0) {
            while ((unsigned)__builtin_amdgcn_readfirstlane(__hip_atomic_load(cnt + 16 * u.pm, __ATOMIC_RELAXED, __HIP_MEMORY_SCOPE_AGENT)) < 32u) __builtin_amdgcn_s_sleep(2);
            __builtin_amdgcn_fence(__ATOMIC_ACQUIRE, "agent");
            asm volatile("s_waitcnt vmcnt(0)" ::: "memory"); }
        asm volatile("s_waitcnt lgkmcnt(0)\n\ts_barrier" ::: "memory");
        if (ln < 32) { const float* pp = part + ((size_t)u.pm * 256 + row) * 4;
            const float s = (__hip_atomic_load(pp, __ATOMIC_RELAXED, __HIP_MEMORY_SCOPE_AGENT) + __hip_atomic_load(pp + 1, __ATOMIC_RELAXED, __HIP_MEMORY_SCOPE_AGENT))
                          + (__hip_atomic_load(pp + 2, __ATOMIC_RELAXED, __HIP_MEMORY_SCOPE_AGENT) + __hip_atomic_load(pp + 3, __ATOMIC_RELAXED, __HIP_MEMORY_SCOPE_AGENT));
            ls[1024 + row] = rsqrtf(s * (1.f / 1024.f) + EPS); }
        PG8_LBAR();
        float rs[2][4];
#pragma unroll
        for (int ai = 0; ai < 2; ++ai)
#pragma unroll
            for (int m = 0; m < 4; ++m) rs[ai][m] = ls[1024 + ai * HALF + m * 16 + lrow];
#pragma unroll
        for (int bj = 0; bj < 2; ++bj) {
            const int c = col0 + bj * HALF;
            f32x4 gm0 = *(const f32x4*)(g + c), gm1 = *(const f32x4*)(g + c + 4), sh0 = (f32x4){0.f, 0.f, 0.f, 0.f}, sh1 = sh0;
            if (!FINAL) { const f32x4 s0 = *(const f32x4*)(sc + (size_t)b * 6144 + c), s1 = *(const f32x4*)(sc + (size_t)b * 6144 + c + 4);
                gm0 = gm0 * (1.f + s0); gm1 = gm1 * (1.f + s1); sh0 = *(const f32x4*)(sh + (size_t)b * 6144 + c); sh1 = *(const f32x4*)(sh + (size_t)b * 6144 + c + 4); }
#pragma unroll
            for (int ai = 0; ai < 2; ++ai)
#pragma unroll
                for (int m = 0; m < 4; ++m) { const size_t off = (size_t)(u.pm * BM + ai * HALF + wr * 64 + m * 16 + fr) * ldc + c;
                    const f32x4 x0 = xv[ai][bj][m][0], x1 = xv[ai][bj][m][1]; const float r = rs[ai][m];
                    if (FINAL) { *(f32x4*)(fout + off) = x0 * r * gm0; *(f32x4*)(fout + off + 4) = x1 * r * gm1; }
                    else { const f32x4 h0 = x0 * r * gm0 + sh0, h1 = x1 * r * gm1 + sh1;
                        u32x4 q; q.x = cvt_pk_bf16(h0[0], h0[1]); q.y = cvt_pk_bf16(h0[2], h0[3]); q.z = cvt_pk_bf16(h1[0], h1[1]); q.w = cvt_pk_bf16(h1[2], h1[3]);
                        *(u32x4*)(h + off) = q; } } }
#undef PG8_LBAR
    }
};

template <class Epi, class Sched, bool ALIGN_EPI = false, bool SP2 = false>
__device__ __forceinline__ void gemm_phase(PG8_LAS unsigned char* lds, const Gemm g, const Sched& S, const Epi& E) {
    const int tid = launder_v((int)threadIdx.x), wid = __builtin_amdgcn_readfirstlane(tid >> 6), lane = tid & 63, wr = wid >> 2, wc = wid & 3, fr = lane & 15, fq = lane >> 4;
    const int K = g.K, nt = K / BK;
    unsigned voffA[2], voffB[2];
#pragma unroll
    for (int i = 0; i < 2; ++i) { int R, C; stage_rc(tid * 16 + i * 8192, R, C); const int Rb = Epi::PERM ? ((R & ~31) + perm32(R & 31)) : R;
        voffA[i] = (unsigned)(R * K + C) * 2u; voffB[i] = (unsigned)(Rb * K + C) * 2u; }
    const size_t kstep = (size_t)(BK * 2);
    const size_t hstep = (size_t)HALF * K * 2;
    const size_t tstep = 2 * hstep;
    const unsigned ldsw = (unsigned)wid * 1024u;
    const int aoff = lds_byte(wr * 64 + fr, fq * 8), boff = lds_byte(wc * 32 + fr, fq * 8);
#define PG8_SA(b, h) (((b) * 2 + (h)) * HTB)
#define PG8_SB(b, h) ((4 + (b) * 2 + (h)) * HTB)
#define PG8_STAGE(bufoff, gbase, voff) do { _Pragma("unroll") for (int _i = 0; _i < 2; ++_i) \
        __builtin_amdgcn_global_load_lds((const unsigned*)((const char*)(gbase) + (voff)[_i]), (PG8_LAS unsigned*)(lds + (bufoff) + ldsw + _i * 8192), 16, 0, 0); } while (0)
#define PG8_LDA(dst, b, h) do { _Pragma("unroll") for (int m = 0; m < 4; ++m) _Pragma("unroll") for (int k = 0; k < 2; ++k) dst[m][k] = *(const PG8_LAS bf16x8*)(lds + PG8_SA(b, h) + aoff + m * 2048 + k * 1024); } while (0)
#define PG8_LDB(dst, b, h) do { _Pragma("unroll") for (int n = 0; n < 2; ++n) _Pragma("unroll") for (int k = 0; k < 2; ++k) dst[n][k] = *(const PG8_LAS bf16x8*)(lds + PG8_SB(b, h) + boff + n * 2048 + k * 1024); } while (0)
#define PG8_MMA(ai, bj, At, Bt) do { __builtin_amdgcn_s_setprio(1); _Pragma("unroll") for (int m = 0; m < 4; ++m) _Pragma("unroll") for (int n = 0; n < 2; ++n) _Pragma("unroll") for (int k = 0; k < 2; ++k) \
        acc[ai][bj][m][n] = __builtin_amdgcn_mfma_f32_16x16x32_bf16(Bt[n][k], At[m][k], acc[ai][bj][m][n], 0, 0, 0); __builtin_amdgcn_s_setprio(0); } while (0)
#define PG8_WAIT_V(n) asm volatile("s_waitcnt vmcnt(" #n ")" ::: "memory")
#define PG8_WAIT_L(n) asm volatile("s_waitcnt lgkmcnt(" #n ")" ::: "memory")
#define PG8_BAR __builtin_amdgcn_s_barrier()
#define PG8_SCHED __builtin_amdgcn_sched_barrier(0)
    Unit cur, nxt; int ui = 0;
    if (!S.next(0, cur)) return;
    f32x4 acc[2][2][4][2];
#pragma unroll
    for (int a = 0; a < 2; ++a)
#pragma unroll
        for (int b = 0; b < 2; ++b)
#pragma unroll
            for (int m = 0; m < 4; ++m)
#pragma unroll
                for (int n = 0; n < 2; ++n) acc[a][b][m][n] = (f32x4){0.f, 0.f, 0.f, 0.f};
    bf16x8 At[4][2], B0[2][2], B1[2][2];
    const char* cA = (const char*)g.A + (size_t)cur.pm * tstep; const char* cB = (const char*)g.Bt + (size_t)cur.pn * tstep;
    S.a_ready(cur);
    if constexpr (SP2) {
        PG8_STAGE(PG8_SB(0, 0), cB, voffB); PG8_STAGE(PG8_SB(0, 1), cB + hstep, voffB); PG8_STAGE(PG8_SA(0, 0), cA, voffA); PG8_STAGE(PG8_SA(0, 1), cA + hstep, voffA);
        if (wr == 1) PG8_BAR;
        PG8_WAIT_V(2); PG8_BAR;
        PG8_STAGE(PG8_SB(1, 0), cB + kstep, voffB); PG8_STAGE(PG8_SA(1, 0), cA + kstep, voffA); PG8_STAGE(PG8_SB(1, 1), cB + hstep + kstep, voffB);
        PG8_WAIT_V(6); PG8_BAR;
    } else {
        PG8_STAGE(PG8_SB(0, 0), cB, voffB); PG8_STAGE(PG8_SA(0, 0), cA, voffA); PG8_STAGE(PG8_SB(0, 1), cB + hstep, voffB); PG8_STAGE(PG8_SA(0, 1), cA + hstep, voffA);
        if (wr == 1) PG8_BAR;
        PG8_WAIT_V(4); PG8_BAR;
        PG8_STAGE(PG8_SB(1, 0), cB + kstep, voffB); PG8_STAGE(PG8_SA(1, 0), cA + kstep, voffA); PG8_STAGE(PG8_SB(1, 1), cB + hstep + kstep, voffB);
        PG8_WAIT_V(6); PG8_BAR;
    }
    for (;;) {
        const bool has_next = S.next(ui + 1, nxt);
        const char* nA = has_next ? (const char*)g.A + (size_t)nxt.pm * tstep : cA; const char* nB = has_next ? (const char*)g.Bt + (size_t)nxt.pn * tstep : cB;
        for (int t = 0; t < nt; t += 2) {
            const bool last = (t == nt - 2);
            const char* a1 = cA + (size_t)(t + 1) * kstep;
            const char* a2 = last ? nA : cA + (size_t)(t + 2) * kstep; const char* b2 = last ? nB : cB + (size_t)(t + 2) * kstep;
            const char* a3 = a2 + kstep; const char* b3 = b2 + kstep;
            if (last && has_next) S.a_ready(nxt);
            if constexpr (SP2) {
            PG8_LDB(B0, 0, 0); PG8_LDB(B1, 0, 1); PG8_SCHED; PG8_LDA(At, 0, 0); PG8_STAGE(PG8_SA(1, 1), a1 + hstep, voffA);
            PG8_WAIT_V(8); PG8_WAIT_L(0); PG8_BAR; PG8_MMA(0, 0, At, B0); PG8_MMA(0, 1, At, B1); PG8_BAR; PG8_SCHED;
            PG8_LDA(At, 0, 1); PG8_STAGE(PG8_SB(0, 0), b2, voffB); PG8_STAGE(PG8_SB(0, 1), b2 + hstep, voffB); PG8_STAGE(PG8_SA(0, 0), a2, voffA);
            PG8_WAIT_V(8); PG8_WAIT_L(0); PG8_BAR; PG8_MMA(1, 0, At, B0); PG8_MMA(1, 1, At, B1); PG8_BAR; PG8_SCHED;
            PG8_LDB(B0, 1, 0); PG8_LDB(B1, 1, 1); PG8_SCHED; PG8_LDA(At, 1, 0); PG8_STAGE(PG8_SA(0, 1), a2 + hstep, voffA);
            PG8_WAIT_V(8); PG8_WAIT_L(0); PG8_BAR; PG8_MMA(0, 0, At, B0); PG8_MMA(0, 1, At, B1); PG8_BAR; PG8_SCHED;
            PG8_LDA(At, 1, 1); PG8_STAGE(PG8_SB(1, 0), b3, voffB); PG8_STAGE(PG8_SB(1, 1), b3 + hstep, voffB); PG8_STAGE(PG8_SA(1, 0), a3, voffA);
            PG8_WAIT_V(8); PG8_WAIT_L(0); PG8_BAR; PG8_MMA(1, 0, At, B0); PG8_MMA(1, 1, At, B1); PG8_BAR; PG8_SCHED;
            } else {
            PG8_LDB(B0, 0, 0); PG8_SCHED; PG8_LDA(At, 0, 0); PG8_STAGE(PG8_SA(1, 1), a1 + hstep, voffA);
            PG8_WAIT_L(8); PG8_BAR; PG8_WAIT_L(0); PG8_MMA(0, 0, At, B0); PG8_BAR; PG8_SCHED;
            PG8_LDB(B1, 0, 1); PG8_STAGE(PG8_SB(0, 0), b2, voffB);
            PG8_BAR; PG8_WAIT_L(0); PG8_MMA(0, 1, At, B1); PG8_BAR;
            PG8_LDA(At, 0, 1); PG8_STAGE(PG8_SA(0, 0), a2, voffA);
            PG8_BAR; PG8_WAIT_L(0); PG8_MMA(1, 0, At, B0); PG8_BAR; PG8_SCHED;
            PG8_STAGE(PG8_SB(0, 1), b2 + hstep, voffB);
            PG8_WAIT_V(6); PG8_BAR; PG8_MMA(1, 1, At, B1); PG8_BAR;
            PG8_LDB(B0, 1, 0); PG8_SCHED; PG8_LDA(At, 1, 0); PG8_STAGE(PG8_SA(0, 1), a2 + hstep, voffA);
            PG8_WAIT_L(8); PG8_BAR; PG8_WAIT_L(0); PG8_MMA(0, 0, At, B0); PG8_BAR; PG8_SCHED;
            PG8_LDB(B1, 1, 1); PG8_STAGE(PG8_SB(1, 0), b3, voffB);
            PG8_BAR; PG8_WAIT_L(0); PG8_MMA(0, 1, At, B1); PG8_BAR;
            PG8_LDA(At, 1, 1); PG8_STAGE(PG8_SA(1, 0), a3, voffA);
            PG8_BAR; PG8_WAIT_L(0); PG8_MMA(1, 0, At, B0); PG8_BAR; PG8_SCHED;
            PG8_STAGE(PG8_SB(1, 1), b3 + hstep, voffB);
            PG8_WAIT_V(6); PG8_BAR; PG8_MMA(1, 1, At, B1); PG8_BAR;
            }
        }
        if constexpr (ALIGN_EPI) { if (wr == 0) PG8_BAR; }
        if constexpr (!Epi::AFTER_DRAIN) { E(acc, cur, wr, wc, fr, fq); S.done(cur); }
        if (!has_next) break;
#pragma unroll
        for (int a = 0; a < 2; ++a)
#pragma unroll
            for (int b = 0; b < 2; ++b)
#pragma unroll
                for (int m = 0; m < 4; ++m)
#pragma unroll
                    for (int n = 0; n < 2; ++n) acc[a][b][m][n] = (f32x4){0.f, 0.f, 0.f, 0.f};
        cur = nxt; cA = nA; cB = nB; ++ui;
        if constexpr (ALIGN_EPI) { if (wr == 1) PG8_BAR; }
    }
    PG8_WAIT_V(0);
    if constexpr (!ALIGN_EPI) { if (wr == 0) PG8_BAR; }
    PG8_BAR;
    if constexpr (Epi::AFTER_DRAIN) { E.fused(acc, cur, wr, wc, fr, fq, lds, wid, lane); S.done(cur); }
#undef PG8_SA
#undef PG8_SB
#undef PG8_STAGE
#undef PG8_LDA
#undef PG8_LDB
#undef PG8_MMA
#undef PG8_WAIT_V
#undef PG8_WAIT_L
#undef PG8_BAR
#undef PG8_SCHED
}
}

namespace att {
using bf16x8 = __attribute__((ext_vector_type(8))) short;
using s16x4 = __attribute__((ext_vector_type(4))) short;
using f32x16 = __attribute__((ext_vector_type(16))) float;
using u32x4 = __attribute__((ext_vector_type(4))) unsigned;
typedef short v4i16_t __attribute__((ext_vector_type(4)));
typedef __attribute__((address_space(3))) const char* lds_cptr;
constexpr int NW = 8, QB = 256, KVBLK = 64, NT = SEQ / KVBLK;
constexpr int NSLOT = 4, SLOTB = 8192;
constexpr int LDS_K = 0, LDS_V = NSLOT * SLOTB, LDS_WS = 2 * NSLOT * SLOTB, LDS_OST = LDS_WS + NW * 128 * 4, LDS_BYTES = LDS_OST + NW * 32 * 64 * 4;
__device__ __forceinline__ int crow(int r, int hi) { return (r & 3) + 8 * (r >> 2) + 4 * hi; }
__device__ __forceinline__ void glds16(const void* gsrc, unsigned lds_dst) { unsigned keep;
    asm volatile("s_mov_b32 %0, m0\n\ts_mov_b32 m0, %2\n\ts_nop 0\n\tglobal_load_lds_dwordx4 %1, off\n\ts_mov_b32 m0, %0" : "=&s"(keep) : "v"(gsrc), "s"(lds_dst) : "memory"); }
typedef float f32x2_t __attribute__((ext_vector_type(2))); typedef __bf16 bf16x2_t __attribute__((ext_vector_type(2)));
__device__ __forceinline__ unsigned cvtpk_s(float lo, float hi) { f32x2_t v = {lo, hi}; bf16x2_t b = __builtin_convertvector(v, bf16x2_t); return __builtin_bit_cast(unsigned, b); }
__device__ __forceinline__ s16x4 vtr(lds_cptr p) { return __builtin_bit_cast(s16x4, __builtin_amdgcn_ds_read_tr16_b64_v4i16((__attribute__((address_space(3))) v4i16_t*)p)); }
#define ATT_WAIT_BAR(N) asm volatile("s_waitcnt vmcnt(" #N ") lgkmcnt(0)\n\ts_barrier" ::: "memory")

__device__ __forceinline__ float max3f(float a, float b, float c) { float r; asm("v_max3_f32 %0, %1, %2, %3" : "=v"(r) : "v"(a), "v"(b), "v"(c)); return r; }
__device__ __forceinline__ float fadd_s(float a, float b) { float r; asm("v_add_f32_e32 %0, %1, %2" : "=v"(r) : "v"(a), "v"(b)); return r; }
__device__ __forceinline__ float max2f(float a, float b) { float r; asm("v_max_f32_e32 %0, %1, %2" : "=v"(r) : "v"(a), "v"(b)); return r; }
#define ATT_DIAG_BIAS(s0, s1) do { const float dqh_ = dq - (float)(4 * hi); _Pragma("unroll") for (int r = 0; r < 16; ++r) { const float c_ = (float)((r & 3) + 8 * (r >> 2)); \
        s0[r] = __builtin_fmaf(-sl, __builtin_fabsf(dqh_ - c_), s0[r]); s1[r] = __builtin_fmaf(-sl, __builtin_fabsf(dqh_ - (c_ + 32.f)), s1[r]); } } while (0)
template <bool FIRST>
__device__ __forceinline__ float softmax_exact(f32x16& s0, f32x16& s1, float& mhat, float& lreg, f32x16& o0, f32x16& o1, float* wsf_f, const int r32, const int hi) {
    float ra = max3f(s0[0], s0[1], s1[0]), rb = max3f(s0[2], s0[3], s1[1]); ra = max3f(ra, s1[2], s1[3]);
#pragma unroll
    for (int r = 4; r < 16; r += 4) { ra = max3f(ra, s0[r], s0[r + 1]); rb = max3f(rb, s0[r + 2], s0[r + 3]); ra = max3f(ra, s1[r], s1[r + 1]); rb = max3f(rb, s1[r + 2], s1[r + 3]); }
    float rm = max2f(ra, rb);
    { auto rr = __builtin_amdgcn_permlane32_swap(__float_as_uint(rm), __float_as_uint(rm), false, false); rm = max2f(__uint_as_float(rr[0]), __uint_as_float(rr[1])); }
    const float dl = FIRST ? rm : max2f(rm, 0.f);
    mhat += dl;
    if (!FIRST) {
        const float f = __builtin_amdgcn_exp2f(-dl); lreg *= f;
        if (hi == 0) wsf_f[r32] = f;
        asm volatile("s_waitcnt lgkmcnt(0)" ::: "memory");
#pragma unroll
        for (int r = 0; r < 16; ++r) { const float fr = wsf_f[crow(r, hi)]; o0[r] *= fr; o1[r] *= fr; }
        asm volatile("" ::: "memory");
    }
    float sacc = 0.f;
#pragma unroll
    for (int r = 0; r < 16; ++r) { s0[r] = __builtin_amdgcn_exp2f(s0[r] - dl); s1[r] = __builtin_amdgcn_exp2f(s1[r] - dl); sacc += s0[r] + s1[r]; }
    return sacc;
}
#define ATT_PIN(x) asm volatile("" : "+v"(x))
#define ATT_EXPSUM(s0, s1, acc) do { float c0_ = 0.f, c1_ = 0.f, c2_ = 0.f, c3_ = 0.f; \
    _Pragma("unroll") for (int r = 0; r < 16; r += 2) { s0[r] = __builtin_amdgcn_exp2f(s0[r]); s1[r] = __builtin_amdgcn_exp2f(s1[r]); s0[r + 1] = __builtin_amdgcn_exp2f(s0[r + 1]); s1[r + 1] = __builtin_amdgcn_exp2f(s1[r + 1]); \
        c0_ += s0[r]; ATT_PIN(c0_); c1_ += s1[r]; ATT_PIN(c1_); c2_ += s0[r + 1]; ATT_PIN(c2_); c3_ += s1[r + 1]; ATT_PIN(c3_); } \
    c0_ += c1_; ATT_PIN(c0_); c2_ += c3_; ATT_PIN(c2_); acc = c0_ + c2_; } while (0)
#define ATT_PACK(s0, s1, pw0, pw1, pw2, pw3) do { \
    pw0 = (u32x4){cvtpk_s(s0[0], s0[1]), cvtpk_s(s0[2], s0[3]), cvtpk_s(s0[4], s0[5]), cvtpk_s(s0[6], s0[7])}; \
    pw1 = (u32x4){cvtpk_s(s0[8], s0[9]), cvtpk_s(s0[10], s0[11]), cvtpk_s(s0[12], s0[13]), cvtpk_s(s0[14], s0[15])}; \
    pw2 = (u32x4){cvtpk_s(s1[0], s1[1]), cvtpk_s(s1[2], s1[3]), cvtpk_s(s1[4], s1[5]), cvtpk_s(s1[6], s1[7])}; \
    pw3 = (u32x4){cvtpk_s(s1[8], s1[9]), cvtpk_s(s1[10], s1[11]), cvtpk_s(s1[12], s1[13]), cvtpk_s(s1[14], s1[15])}; } while (0)
__device__ __forceinline__ float bfr(float x) { return __uint_as_float(cvtpk_s(x, 0.f) << 16); }
__device__ __forceinline__ bf16x8 make_qaug(const float a, const float sgs1, const unsigned w2, const unsigned h0, const unsigned h1, const int hi) {
    const float r1 = a - bfr(a), r2 = r1 - bfr(r1);
    u32x4 w; w.x = cvtpk_s(a, r1); w.y = cvtpk_s(r2, sgs1); w.z = w2; w.w = 0u;
    if (hi) { w.x = h0; w.y = h1; w.z = 0u; }
    return __builtin_bit_cast(bf16x8, w);
}

template <int THRL, int SKIP_T, int ABL = 0>
__device__ __forceinline__ void attn_unit(const int b, const int h, const int qb, const bf16_t* __restrict__ proj, bf16_t* __restrict__ mix, const float* __restrict__ gsub,
                                          const float lam, const float oscale, const unsigned* __restrict__ kn2, char* shm) {
    const int tid = launder_v((int)threadIdx.x), lane = tid & 63, r32 = lane & 31, hi = lane >> 5; const int wid = __builtin_amdgcn_readfirstlane(tid >> 6);
    const int grp = wid >> 2;
    const long rowbase = (long)b * SEQ; const int q0 = qb * QB;
    const float sl0 = __builtin_amdgcn_exp2f(-(float)(h + 1)) * LOG2E;
    const float s1 = bfr(sl0), s2 = bfr(sl0 - s1), s3 = bfr(sl0 - s1 - s2); const float sl = s1 + s2 + s3;
    const bf16_t* Qw = proj + (rowbase + q0 + wid * 32) * INW + O_Q + h * 64;
    const bf16_t* Kh = proj + rowbase * INW + O_K + h * 64; const bf16_t* Vh = proj + rowbase * INW + O_V + h * 64;
    const unsigned lds0 = (unsigned)(uintptr_t)shm;
    float* wsf = (float*)(shm + LDS_WS) + wid * 128;
    const bf16_t* ksrc = Kh + (long)(16 * (wid & 3) + (lane >> 2)) * INW + (wid >> 2) * 32 + (((lane & 3) ^ ((lane >> 4) & 3))) * 8;
    const bf16_t* vsrc = Vh + (long)(16 * (wid & 3) + (lane >> 2)) * INW + (wid >> 2) * 32 + (lane & 3) * 8;
    const unsigned kdst = lds0 + LDS_K + wid * 1024, vdst = lds0 + LDS_V + wid * 1024;
    const int d0t = 4 * qb;
    int nR = NT - d0t, NTe = NT;
    const int td = d0t + (wid >> 1);
#define ATT_TAU(i) ((i) < nR ? d0t + (i) : d0t - 1 - ((i) - nR))
#define ATT_DMA(i, slot) do { if (ABL & 1) break; const long off_ = (long)ATT_TAU(i) * KVBLK * INW; \
        glds16(ksrc + off_, (unsigned)__builtin_amdgcn_readfirstlane(kdst + (slot) * SLOTB)); glds16(vsrc + off_, (unsigned)__builtin_amdgcn_readfirstlane(vdst + (slot) * SLOTB)); } while (0)
#define ATT_BARV(N) do { if (ABL & 16) asm volatile("s_waitcnt vmcnt(" #N ") lgkmcnt(0)\n\ts_nop 11" ::: "memory"); else asm volatile("s_waitcnt vmcnt(" #N ") lgkmcnt(0)\n\ts_barrier\n\ts_nop 11" ::: "memory"); } while (0)
#define ATT_BAR() do { if (ABL & 16) asm volatile("s_waitcnt lgkmcnt(0)" ::: "memory"); else asm volatile("s_waitcnt lgkmcnt(0)\n\ts_barrier" ::: "memory"); } while (0)
#define ATT_SB() __builtin_amdgcn_sched_barrier(0)
    bf16x8 qr[4];
#pragma unroll
    for (int d0 = 0; d0 < 4; ++d0) qr[d0] = *reinterpret_cast<const bf16x8*>(&Qw[(long)r32 * INW + d0 * 16 + hi * 8]);
    float ka2 = 0.f, kb2 = 0.f;
    if (SKIP_T > 0) { const unsigned* knp = kn2 + ((b * 8 + h) * 2) * 64;
        ka2 = __uint_as_float(__hip_atomic_load(knp + lane, __ATOMIC_RELAXED, __HIP_MEMORY_SCOPE_AGENT)); kb2 = __uint_as_float(__hip_atomic_load(knp + 64 + lane, __ATOMIC_RELAXED, __HIP_MEMORY_SCOPE_AGENT)); }
    const bf16_t* Kq = Kh + (long)(q0 + wid * 32 + r32) * INW + hi * 8;
    bf16x8 kk[4];
    if (SKIP_T > 0) {
#pragma unroll
        for (int d0 = 0; d0 < 4; ++d0) kk[d0] = *reinterpret_cast<const bf16x8*>(Kq + d0 * 16); }
    ATT_DMA(0, 0); ATT_DMA(1, 1);
    float dra = 0.f, drb = 0.f;
    if (SKIP_T > 0) {
        float qa2 = 0.f, qb2 = 0.f;
#pragma unroll
        for (int d0 = 0; d0 < 4; ++d0) {
#pragma unroll
            for (int j = 0; j < 8; ++j) { const float qv = bf2f((bf16_t)qr[d0][j]), kv = bf2f((bf16_t)kk[d0][j]); if (d0 < 2) { qa2 += qv * qv; dra += qv * kv; } else { qb2 += qv * qv; drb += qv * kv; } } }
        qa2 += __shfl_xor(qa2, 32); qb2 += __shfl_xor(qb2, 32); dra += __shfl_xor(dra, 32); drb += __shfl_xor(drb, 32);
#pragma unroll
        for (int o = 1; o < 32; o <<= 1) { qa2 = fmaxf(qa2, __shfl_xor(qa2, o)); qb2 = fmaxf(qb2, __shfl_xor(qb2, o)); }
        if (lane == 0) { wsf[0] = qa2; wsf[1] = qb2; }
    }
    { __attribute__((address_space(3))) bf16x8* qst_ = (__attribute__((address_space(3))) bf16x8*)((lds_cptr)shm + LDS_OST + wid * 8192) + lane;
#pragma unroll
      for (int d0 = 0; d0 < 4; ++d0) qst_[d0 * 64] = qr[d0]; }
    const lds_cptr qp = (lds_cptr)shm + LDS_OST + wid * 8192 + lane * 16;
#define ATT_LDQ() const bf16x8 qf0 = *(const __attribute__((address_space(3))) bf16x8*)(qp), qf1 = *(const __attribute__((address_space(3))) bf16x8*)(qp + 1024), qf2 = *(const __attribute__((address_space(3))) bf16x8*)(qp + 2048), qf3 = *(const __attribute__((address_space(3))) bf16x8*)(qp + 3072)
    bf16x8 kaug0, kaug1;
    { const unsigned sb0 = (unsigned)f2bf((float)r32), sb1 = (unsigned)f2bf((float)(r32 + 32));
      u32x4 w0 = (u32x4){0x3F803F80u, (sb0 << 16) | 0x3F80u, (sb0 << 16) | sb0, 0u}, w1 = (u32x4){0x3F803F80u, (sb1 << 16) | 0x3F80u, (sb1 << 16) | sb1, 0u};
      if (hi) { w0 = (u32x4){0u, 0u, 0u, 0u}; w1 = w0; }
      kaug0 = __builtin_bit_cast(bf16x8, w0); kaug1 = __builtin_bit_cast(bf16x8, w1); }
    const unsigned w2pos = cvtpk_s(s2, s3), w2neg = cvtpk_s(-s2, -s3), h0pos = cvtpk_s(s1, s2), h0neg = cvtpk_s(-s1, -s2), h1pos = cvtpk_s(s3, 0.f), h1neg = cvtpk_s(-s3, 0.f);
    float mhatA = 0.f, mhatB = 0.f, lA = 0.f, lB = 0.f;
    f32x16 oa0 = f32x16{}, oa1 = f32x16{}, ob0 = f32x16{}, ob1 = f32x16{};
    f32x16 sa0, sa1, sb0, sb1;
    u32x4 pa0, pa1, pa2, pa3, pb0, pb1, pb2, pb3;
    bf16x8 qaA, qaB;
    const lds_cptr shm3 = (lds_cptr)shm;
    const lds_cptr kp0 = (lds_cptr)shm + LDS_K + (r32 >> 4) * 1024 + (r32 & 15) * 64 + ((hi) ^ ((r32 >> 2) & 3)) * 16;
    const int koB = (((2 + hi) ^ ((r32 >> 2) & 3)) - ((hi) ^ ((r32 >> 2) & 3))) * 16;
    const lds_cptr vp0 = shm3 + LDS_V + ((lane >> 4) & 1) * 32 + (lane & 3) * 8 + (4 * hi + ((lane & 15) >> 2)) * 64;
    const int tq = q0 + wid * 32 + r32;
    const f32x16 zero = f32x16{};
#define ATT_KA(off) (*(const __attribute__((address_space(3))) bf16x8*)(kp + (off)))
#define ATT_KB(off) (*(const __attribute__((address_space(3))) bf16x8*)(kp + koB + (off)))
#define ATT_VFR(n, ks) const s16x4 l0##n = vtr(vp + (ks) * 1024), h0##n = vtr(vp + (ks) * 1024 + 512), l1##n = vtr(vp + 4096 + (ks) * 1024), h1##n = vtr(vp + 4096 + (ks) * 1024 + 512)
#define ATT_PVK(n, PA, PB) do { if (ABL & 4) { asm volatile("" :: "v"(l0##n), "v"(h0##n), "v"(l1##n), "v"(h1##n), "v"(PA), "v"(PB)); break; } const bf16x8 v0_ = (bf16x8){l0##n[0], l0##n[1], l0##n[2], l0##n[3], h0##n[0], h0##n[1], h0##n[2], h0##n[3]}, v1_ = (bf16x8){l1##n[0], l1##n[1], l1##n[2], l1##n[3], h1##n[0], h1##n[1], h1##n[2], h1##n[3]}; \
        const bf16x8 pa_ = __builtin_bit_cast(bf16x8, PA), pb_ = __builtin_bit_cast(bf16x8, PB); \
        oa0 = __builtin_amdgcn_mfma_f32_32x32x16_bf16(pa_, v0_, oa0, 0, 0, 0); oa1 = __builtin_amdgcn_mfma_f32_32x32x16_bf16(pa_, v1_, oa1, 0, 0, 0); \
        ob0 = __builtin_amdgcn_mfma_f32_32x32x16_bf16(pb_, v0_, ob0, 0, 0, 0); ob1 = __builtin_amdgcn_mfma_f32_32x32x16_bf16(pb_, v1_, ob1, 0, 0, 0); } while (0)
#define ATT_QKA() do { if (ABL & 8) { asm volatile("" : "+v"(sa0), "+v"(sa1) : "v"(ka0), "v"(ka1), "v"(ka2), "v"(ka3), "v"(qaA)); break; } sa0 = __builtin_amdgcn_mfma_f32_32x32x16_bf16(kaug0, qaA, zero, 0, 0, 0); sa1 = __builtin_amdgcn_mfma_f32_32x32x16_bf16(kaug1, qaA, zero, 0, 0, 0); \
        sa0 = __builtin_amdgcn_mfma_f32_32x32x16_bf16(ka0, qf0, sa0, 0, 0, 0); sa1 = __builtin_amdgcn_mfma_f32_32x32x16_bf16(ka1, qf0, sa1, 0, 0, 0); \
        sa0 = __builtin_amdgcn_mfma_f32_32x32x16_bf16(ka2, qf1, sa0, 0, 0, 0); sa1 = __builtin_amdgcn_mfma_f32_32x32x16_bf16(ka3, qf1, sa1, 0, 0, 0); } while (0)
#define ATT_QKB() do { if (ABL & 8) { asm volatile("" : "+v"(sb0), "+v"(sb1) : "v"(kb0), "v"(kb1), "v"(kb2), "v"(kb3), "v"(qaB)); break; } sb0 = __builtin_amdgcn_mfma_f32_32x32x16_bf16(kaug0, qaB, zero, 0, 0, 0); sb1 = __builtin_amdgcn_mfma_f32_32x32x16_bf16(kaug1, qaB, zero, 0, 0, 0); \
        sb0 = __builtin_amdgcn_mfma_f32_32x32x16_bf16(kb0, qf2, sb0, 0, 0, 0); sb1 = __builtin_amdgcn_mfma_f32_32x32x16_bf16(kb1, qf2, sb1, 0, 0, 0); \
        sb0 = __builtin_amdgcn_mfma_f32_32x32x16_bf16(kb2, qf3, sb0, 0, 0, 0); sb1 = __builtin_amdgcn_mfma_f32_32x32x16_bf16(kb3, qf3, sb1, 0, 0, 0); } while (0)
#define ATT_SIDE(tau_) ((tau_) < td ? 0 : ((tau_) == td ? 1 : 2))
#define ATT_QAUG(sd_) do { const bool left_ = (sd_) == 0, diag_ = (sd_) == 1; const float tsl = sl * (float)tq;     \
        const float aA_ = diag_ ? -mhatA : (left_ ? -tsl - mhatA : tsl - mhatA), aB_ = diag_ ? -mhatB : (left_ ? -tsl - mhatB : tsl - mhatB); \
        const float sgs1_ = diag_ ? 0.f : (left_ ? s1 : -s1); const unsigned w2_ = diag_ ? 0u : (left_ ? w2pos : w2neg), h0_ = diag_ ? 0u : (left_ ? h0pos : h0neg), h1_ = diag_ ? 0u : (left_ ? h1pos : h1neg); \
        qaA = make_qaug(aA_, sgs1_, w2_, h0_, h1_, hi); qaB = make_qaug(aB_, sgs1_, w2_, h0_, h1_, hi); } while (0)
#define ATT_KAUG(tau_) do { const unsigned tb_ = __float_as_uint((float)((tau_) * KVBLK)) >> 16; \
        if (hi) { const u32x4 w_ = (u32x4){tb_ | (tb_ << 16), tb_, 0u, 0u}; kaug0 = __builtin_bit_cast(bf16x8, w_); kaug1 = kaug0; } } while (0)
    ATT_QAUG(ATT_SIDE(d0t)); ATT_KAUG(d0t);
    ATT_BARV(2);
    { ATT_DMA(2, 2);
      const lds_cptr kp = kp0;
      const bf16x8 ka0 = ATT_KA(0), ka1 = ATT_KA(2048), ka2 = ATT_KB(0), ka3 = ATT_KB(2048), kb0 = ATT_KA(4096), kb1 = ATT_KA(6144), kb2 = ATT_KB(4096), kb3 = ATT_KB(6144);
      ATT_LDQ();
      ATT_QKA(); ATT_QKB();
      ATT_SB(); ATT_BARV(2); ATT_SB();
      const bool diag = d0t == td; const float dq = (float)(tq - d0t * KVBLK);
      if (ABL & 2) { asm volatile("" : "=v"(pa0), "=v"(pa1), "=v"(pa2), "=v"(pa3), "=v"(pb0), "=v"(pb1), "=v"(pb2), "=v"(pb3) : "v"(sa0), "v"(sa1), "v"(sb0), "v"(sb1)); } else {
      if (diag) { ATT_DIAG_BIAS(sa0, sa1); ATT_DIAG_BIAS(sb0, sb1); }
      lA = softmax_exact<true>(sa0, sa1, mhatA, lA, oa0, oa1, wsf, r32, hi); lB = softmax_exact<true>(sb0, sb1, mhatB, lB, ob0, ob1, wsf + 32, r32, hi);
      if (SKIP_T > 0) { float la = fmaxf(mhatA, dra), lb = fmaxf(mhatB, drb);
#pragma unroll
          for (int o = 1; o < 32; o <<= 1) { la = fminf(la, __shfl_xor(la, o)); lb = fminf(lb, __shfl_xor(lb, o)); }
          if (lane == 0) { wsf[2] = la; wsf[3] = lb; } }
      ATT_PACK(sa0, sa1, pa0, pa1, pa2, pa3); ATT_PACK(sb0, sb1, pb0, pb1, pb2, pb3); }
      { const int tn_ = ATT_TAU(1); ATT_QAUG(ATT_SIDE(tn_)); ATT_KAUG(tn_); }
      ATT_SB(); ATT_BAR(); ATT_SB(); }
    if (SKIP_T > 0) {
        float qa2 = 0.f, qb2 = 0.f, da = 3.0e38f, db = 3.0e38f;
        { const float* wall = (const float*)(shm + LDS_WS);
#pragma unroll
          for (int w = 0; w < NW; ++w) { qa2 = fmaxf(qa2, wall[w * 128 + 0]); qb2 = fmaxf(qb2, wall[w * 128 + 1]); da = fminf(da, wall[w * 128 + 2]); db = fminf(db, wall[w * 128 + 3]); } }
        const int kt0 = lane * KVBLK; const int dmin = kt0 + KVBLK - 1 < q0 ? q0 - (kt0 + KVBLK - 1) : (kt0 > q0 + QB - 1 ? kt0 - (q0 + QB - 1) : 0);
        const float pen = sl * (float)dmin - (float)SKIP_T;
        const bool needed = dmin == 0 || !(sqrtf(qa2 * ka2) * 1.01f - pen <= da) || !(sqrtf(qb2 * kb2) * 1.01f - pen <= db);
        const unsigned long long mask = __ballot(needed);
        const int tR = 63 - __clzll((long long)mask), tL = __ffsll((long long)mask) - 1;
        nR = __builtin_amdgcn_readfirstlane(tR + 1 - d0t); NTe = __builtin_amdgcn_readfirstlane(tR - tL + 1);
        ATT_BAR();
    }
    if (grp == 1) { ATT_BAR(); }
    for (int i = 1; i < NTe; ++i) {
        const int tau = ATT_TAU(i), slot = i & 3;
        { const int id_ = i + 2 < NTe ? i + 2 : NTe - 1; ATT_DMA(id_, (i + 2) & 3); }
        { const lds_cptr vp = vp0 + ((i - 1) & 3) * SLOTB, kp = kp0 + slot * SLOTB;
          ATT_VFR(a, 0); ATT_VFR(b, 1);
          const bf16x8 ka0 = ATT_KA(0), ka1 = ATT_KA(2048), ka2 = ATT_KB(0), ka3 = ATT_KB(2048);
          ATT_SB();
          ATT_PVK(a, pa0, pb0); ATT_SB();
          ATT_VFR(c, 2); ATT_SB();
          ATT_PVK(b, pa1, pb1); ATT_SB();
          ATT_VFR(d, 3);
          const bf16x8 kb0 = ATT_KA(4096), kb1 = ATT_KA(6144), kb2 = ATT_KB(4096), kb3 = ATT_KB(6144);
          ATT_LDQ();
          ATT_SB();
          ATT_PVK(c, pa2, pb2); ATT_SB();
          ATT_PVK(d, pa3, pb3); ATT_SB();
          ATT_QKA(); ATT_QKB(); }
        ATT_SB();
        ATT_BARV(2);
        __builtin_amdgcn_s_setprio(1);
        ATT_SB();
        { const bool diag = tau == td; const float dq = (float)(tq - tau * KVBLK);
          if (ABL & 2) { asm volatile("" : "=v"(pa0), "=v"(pa1), "=v"(pa2), "=v"(pa3), "=v"(pb0), "=v"(pb1), "=v"(pb2), "=v"(pb3) : "v"(sa0), "v"(sa1), "v"(sb0), "v"(sb1)); } else {
          if (diag) { ATT_DIAG_BIAS(sa0, sa1); ATT_DIAG_BIAS(sb0, sb1); }
          const float big = (float)(1u << THRL);
          bool redo = false;
          { float accA; ATT_EXPSUM(sa0, sa1, accA);
            if (__builtin_expect(__any(!(accA < big)), 0)) { const lds_cptr kp = kp0 + slot * SLOTB;
                const bf16x8 ka0 = ATT_KA(0), ka1 = ATT_KA(2048), ka2 = ATT_KB(0), ka3 = ATT_KB(2048);
                ATT_LDQ();
                ATT_QKA(); asm volatile("s_nop 15\n\ts_nop 7" : "+v"(sa0), "+v"(sa1)); if (diag) ATT_DIAG_BIAS(sa0, sa1);
                accA = softmax_exact<false>(sa0, sa1, mhatA, lA, oa0, oa1, wsf, r32, hi); redo = true; }
            lA += accA; ATT_PACK(sa0, sa1, pa0, pa1, pa2, pa3); }
          ATT_SB();
          { float accB; ATT_EXPSUM(sb0, sb1, accB);
            if (__builtin_expect(__any(!(accB < big)), 0)) { const lds_cptr kp = kp0 + slot * SLOTB;
                const bf16x8 kb0 = ATT_KA(4096), kb1 = ATT_KA(6144), kb2 = ATT_KB(4096), kb3 = ATT_KB(6144);
                ATT_LDQ();
                ATT_QKB(); asm volatile("s_nop 15\n\ts_nop 7" : "+v"(sb0), "+v"(sb1)); if (diag) ATT_DIAG_BIAS(sb0, sb1);
                accB = softmax_exact<false>(sb0, sb1, mhatB, lB, ob0, ob1, wsf + 32, r32, hi); redo = true; }
            lB += accB; ATT_PACK(sb0, sb1, pb0, pb1, pb2, pb3); }
          { const int in_ = i + 1 < NTe ? i + 1 : i; const int tn_ = ATT_TAU(in_); const int sdn_ = ATT_SIDE(tn_);
            if (redo || sdn_ != ATT_SIDE(tau)) { ATT_QAUG(sdn_); }
            ATT_KAUG(tn_); } } }
        __builtin_amdgcn_s_setprio(0);
        ATT_SB(); ATT_BAR(); ATT_SB();
    }
    { const lds_cptr vp = vp0 + ((NTe - 1) & 3) * SLOTB;
      ATT_VFR(a, 0); ATT_VFR(b, 1); ATT_VFR(c, 2); ATT_VFR(d, 3);
      ATT_PVK(a, pa0, pb0); ATT_PVK(b, pa1, pb1); ATT_PVK(c, pa2, pb2); ATT_PVK(d, pa3, pb3); }
    ATT_BAR();
    if (grp == 0) { ATT_BAR(); }
    { auto rr = __builtin_amdgcn_permlane32_swap(__float_as_uint(lA), __float_as_uint(lA), false, false); lA = __uint_as_float(rr[0]) + __uint_as_float(rr[1]); }
    { auto rr = __builtin_amdgcn_permlane32_swap(__float_as_uint(lB), __float_as_uint(lB), false, false); lB = __uint_as_float(rr[0]) + __uint_as_float(rr[1]); }
    if (hi == 0) { wsf[64 + r32] = 1.f / lA; wsf[96 + r32] = lam / lB; }
    asm volatile("s_waitcnt lgkmcnt(0)" ::: "memory");
    float* stg = (float*)(shm + LDS_OST) + wid * 2048;
#pragma unroll
    for (int r = 0; r < 16; ++r) { const int orow = crow(r, hi); const float a = wsf[64 + orow], c = wsf[96 + orow];
        stg[orow * 64 + r32] = oa0[r] * a - ob0[r] * c; stg[orow * 64 + 32 + r32] = oa1[r] * a - ob1[r] * c; }
    asm volatile("s_waitcnt lgkmcnt(0)" ::: "memory");
    bf16_t* Ow = mix + (rowbase + q0 + wid * 32) * D + h * 64;
    const int ch = lane & 7;
    const float4 g0 = *(const float4*)(gsub + ch * 8), g1 = *(const float4*)(gsub + ch * 8 + 4);
#pragma unroll
    for (int i = 0; i < 4; ++i) { const int row = i * 8 + (lane >> 3);
        const float4 a = *(const float4*)(stg + row * 64 + ch * 8), c = *(const float4*)(stg + row * 64 + ch * 8 + 4);
        float ss = a.x * a.x + a.y * a.y + a.z * a.z + a.w * a.w + c.x * c.x + c.y * c.y + c.z * c.z + c.w * c.w;
        ss += __shfl_xor(ss, 1); ss += __shfl_xor(ss, 2); ss += __shfl_xor(ss, 4);
        const float rn = rsqrtf(ss * (1.f / 64.f) + EPS) * oscale;
        u32x4 w; w.x = cvtpk_s(a.x * rn * g0.x, a.y * rn * g0.y); w.y = cvtpk_s(a.z * rn * g0.z, a.w * rn * g0.w); w.z = cvtpk_s(c.x * rn * g1.x, c.y * rn * g1.y); w.w = cvtpk_s(c.z * rn * g1.z, c.w * rn * g1.w);
        *(u32x4*)(Ow + (long)row * D + ch * 8) = w; }
    asm volatile("s_waitcnt lgkmcnt(0)" ::: "memory");
#undef ATT_TAU
#undef ATT_DMA
#undef ATT_BARV
#undef ATT_BAR
#undef ATT_SB
#undef ATT_KA
#undef ATT_KB
#undef ATT_LDQ
#undef ATT_VFR
#undef ATT_PVK
#undef ATT_QKA
#undef ATT_QKB
#undef ATT_QAUG
#undef ATT_KAUG
#undef ATT_SIDE
}
#undef ATT_WAIT_BAR
#undef ATT_DIAG_BIAS
#undef ATT_PACK
#undef ATT_EXPSUM
#undef ATT_PIN
}

constexpr int NWAVES = 8, NTHR = NWAVES * 64;
constexpr int RING_BYTES = 139264;
constexpr int MISC_OFF = RING_BYTES;
constexpr int LDS_BYTES = 147456;
static_assert(MISC_OFF + 128 <= LDS_BYTES && att::LDS_BYTES <= RING_BYTES, "LDS map");

__device__ __forceinline__ float wave_sum(float v) {
#pragma unroll
    for (int o = 1; o < 64; o <<= 1) v += __shfl_xor(v, o);
    return v;
}
__device__ __forceinline__ void p0_transpose_item(const float* __restrict__ W, int K, int N, bf16_t* __restrict__ WT, int k0, int n0, int dst_row0, LAS float* scr, int lane) {
    float4 v[16]; const int kr = lane >> 4, c4 = (lane & 15) * 4;
#pragma unroll
    for (int i = 0; i < 16; ++i) v[i] = *(const float4*)(W + (size_t)(k0 + 4 * i + kr) * N + n0 + c4);
#pragma unroll
    for (int i = 0; i < 16; ++i) { LAS float* d = scr + (4 * i + kr) * 65 + c4; d[0] = v[i].x; d[1] = v[i].y; d[2] = v[i].z; d[3] = v[i].w; }
    LDS_WAIT(); asm volatile("" ::: "memory");
    const int c = lane & 7;
#pragma unroll
    for (int j = 0; j < 8; ++j) { const int n = (lane >> 3) + 8 * j; const LAS float* s = scr + (8 * c) * 65 + n;
        uint4 o; o.x = pk2(s[0 * 65], s[1 * 65]); o.y = pk2(s[2 * 65], s[3 * 65]); o.z = pk2(s[4 * 65], s[5 * 65]); o.w = pk2(s[6 * 65], s[7 * 65]);
        *(uint4*)(WT + (size_t)(dst_row0 + n) * K + k0 + 8 * c) = o; }
    LDS_WAIT(); asm volatile("" ::: "memory");
}
__device__ __forceinline__ void p0_transpose_matrix(const float* W, int K, int N, bf16_t* WT, bool interleave, LAS float* scr, int gw, int ngw, int lane, int& cursor) {
    const int nkb = K / 64, nnb = N / 64, nitems = nkb * nnb;
    int first = ((gw - cursor) % ngw + ngw) % ngw;
    for (int it = first; it < nitems; it += ngw) { const int kb = it / nnb, nb = it % nnb; const int n0 = nb * 64;
        int dr = n0; if (interleave) { const int j = n0 < DFF ? n0 : n0 - DFF; dr = (j / 128) * 256 + (j % 128) + (n0 < DFF ? 0 : 128); }
        p0_transpose_item(W, K, N, WT, kb * 64, n0, dr, scr, lane); }
    cursor += nitems;
}
__device__ __forceinline__ void p0_mod_unit(const float* __restrict__ c, const float* __restrict__ w_ada, const float* __restrict__ b_ada, float* __restrict__ mod, int unit, LAS float* lds, int tid) {
    LAS float* sc = lds;
    LAS float* red = lds + 8192;
    const int l = unit / 96, j0 = (unit % 96) * 64, col = tid & 63, kq = tid >> 6;
    for (int i = tid; i < 8192; i += NTHR) { const float v = c[i]; sc[i] = v / (1.f + __expf(-v)); }
    __syncthreads();
    float acc[8] = {0.f, 0.f, 0.f, 0.f, 0.f, 0.f, 0.f, 0.f};
    const float* w = w_ada + (size_t)l * 1024 * 6144 + j0 + col;
    for (int k = kq * 128; k < kq * 128 + 128; k += 16) { float wv[16];
#pragma unroll
        for (int j = 0; j < 16; ++j) wv[j] = w[(size_t)(k + j) * 6144];
#pragma unroll
        for (int j = 0; j < 16; ++j)
#pragma unroll
            for (int b = 0; b < 8; ++b) acc[b] += sc[b * 1024 + k + j] * wv[j]; }
#pragma unroll
    for (int b = 0; b < 8; ++b) red[(kq * 8 + b) * 64 + col] = acc[b];
    __syncthreads();
    { const int b = kq; float s = b_ada[l * 6144 + j0 + col];
#pragma unroll
      for (int q = 0; q < 8; ++q) s += red[(q * 8 + b) * 64 + col];
      mod[((size_t)l * 8 + b) * 6144 + j0 + col] = s; }
    __syncthreads();
}
template <bool XF32, bool MOD, int NR>
__device__ __forceinline__ void norm_rows(const void* __restrict__ x0, const float* __restrict__ g, const float* __restrict__ sh, const float* __restrict__ sc, bf16_t* h0, float* f0, int lane) {
    const int c0 = lane * 16;
    float gm[16], shv[16];
#pragma unroll
    for (int j = 0; j < 4; ++j) { const float4 gv = *(const float4*)(g + c0 + 4 * j); gm[4 * j] = gv.x; gm[4 * j + 1] = gv.y; gm[4 * j + 2] = gv.z; gm[4 * j + 3] = gv.w;
        if (MOD) { const float4 s4 = *(const float4*)(sc + c0 + 4 * j), h4 = *(const float4*)(sh + c0 + 4 * j);
            gm[4 * j] *= 1.f + s4.x; gm[4 * j + 1] *= 1.f + s4.y; gm[4 * j + 2] *= 1.f + s4.z; gm[4 * j + 3] *= 1.f + s4.w; shv[4 * j] = h4.x; shv[4 * j + 1] = h4.y; shv[4 * j + 2] = h4.z; shv[4 * j + 3] = h4.w; } }
    float4 xf[XF32 ? NR : 1][4]; uint4 xh[XF32 ? 1 : NR][2];
#pragma unroll
    for (int r = 0; r < NR; ++r) {
        if (XF32) { const float4* xr = (const float4*)((const float*)x0 + (size_t)r * D) + lane * 4;
#pragma unroll
            for (int j = 0; j < 4; ++j) xf[r][j] = xr[j]; }
        else { const uint4* xr = (const uint4*)((const bf16_t*)x0 + (size_t)r * D) + lane * 2; xh[r][0] = xr[0]; xh[r][1] = xr[1]; } }
#pragma unroll
    for (int r = 0; r < NR; ++r) {
        float v[16];
        if (XF32) {
#pragma unroll
            for (int j = 0; j < 4; ++j) { v[4 * j] = xf[r][j].x; v[4 * j + 1] = xf[r][j].y; v[4 * j + 2] = xf[r][j].z; v[4 * j + 3] = xf[r][j].w; } }
        else {
#pragma unroll
            for (int j = 0; j < 2; ++j) { const uint4 t = xh[r][j];
                v[8 * j] = __uint_as_float(t.x << 16); v[8 * j + 1] = __uint_as_float(t.x & 0xffff0000u); v[8 * j + 2] = __uint_as_float(t.y << 16); v[8 * j + 3] = __uint_as_float(t.y & 0xffff0000u);
                v[8 * j + 4] = __uint_as_float(t.z << 16); v[8 * j + 5] = __uint_as_float(t.z & 0xffff0000u); v[8 * j + 6] = __uint_as_float(t.w << 16); v[8 * j + 7] = __uint_as_float(t.w & 0xffff0000u); } }
        float s = 0.f;
#pragma unroll
        for (int j = 0; j < 16; ++j) s += v[j] * v[j];
        const float rs = rsqrtf(wave_sum(s) * (1.f / D) + EPS);
        if (MOD) { uint4 w0, w1;
            w0.x = pk2(v[0] * rs * gm[0] + shv[0], v[1] * rs * gm[1] + shv[1]); w0.y = pk2(v[2] * rs * gm[2] + shv[2], v[3] * rs * gm[3] + shv[3]);
            w0.z = pk2(v[4] * rs * gm[4] + shv[4], v[5] * rs * gm[5] + shv[5]); w0.w = pk2(v[6] * rs * gm[6] + shv[6], v[7] * rs * gm[7] + shv[7]);
            w1.x = pk2(v[8] * rs * gm[8] + shv[8], v[9] * rs * gm[9] + shv[9]); w1.y = pk2(v[10] * rs * gm[10] + shv[10], v[11] * rs * gm[11] + shv[11]);
            w1.z = pk2(v[12] * rs * gm[12] + shv[12], v[13] * rs * gm[13] + shv[13]); w1.w = pk2(v[14] * rs * gm[14] + shv[14], v[15] * rs * gm[15] + shv[15]);
            uint4* hp = (uint4*)(h0 + (size_t)r * D + c0); hp[0] = w0; hp[1] = w1; }
        else { float4* fp = (float4*)(f0 + (size_t)r * D + c0);
#pragma unroll
            for (int j = 0; j < 4; ++j) fp[j] = make_float4(v[4 * j] * rs * gm[4 * j], v[4 * j + 1] * rs * gm[4 * j + 1], v[4 * j + 2] * rs * gm[4 * j + 2], v[4 * j + 3] * rs * gm[4 * j + 3]); }
    }
}
constexpr int POOL_UP = 528;
template <int HW>
__device__ __forceinline__ void pool_afr(const LAS unsigned char* base, const float inv, __attribute__((ext_vector_type(8))) short (&afr)[4]) {
    typedef unsigned ux4 __attribute__((ext_vector_type(4))); typedef __attribute__((ext_vector_type(8))) short bfx8;
#pragma unroll
    for (int ks = 0; ks < 4; ++ks) {
        float acc[8] = {0.f, 0.f, 0.f, 0.f, 0.f, 0.f, 0.f, 0.f};
#pragma unroll
        for (int o = -HW; o < HW; ++o) { const ux4 v = *(const LAS ux4*)(base + o * POOL_UP + ks * 32);
            acc[0] += __uint_as_float(v.x << 16); acc[1] += __uint_as_float(v.x & 0xffff0000u); acc[2] += __uint_as_float(v.y << 16); acc[3] += __uint_as_float(v.y & 0xffff0000u);
            acc[4] += __uint_as_float(v.z << 16); acc[5] += __uint_as_float(v.z & 0xffff0000u); acc[6] += __uint_as_float(v.w << 16); acc[7] += __uint_as_float(v.w & 0xffff0000u); }
        const ux4 c = *(const LAS ux4*)(base + ks * 32);
        ux4 w; w.x = pk2(acc[0] * inv - __uint_as_float(c.x << 16), acc[1] * inv - __uint_as_float(c.x & 0xffff0000u)); w.y = pk2(acc[2] * inv - __uint_as_float(c.y << 16), acc[3] * inv - __uint_as_float(c.y & 0xffff0000u));
        w.z = pk2(acc[4] * inv - __uint_as_float(c.z << 16), acc[5] * inv - __uint_as_float(c.z & 0xffff0000u)); w.w = pk2(acc[6] * inv - __uint_as_float(c.w << 16), acc[7] * inv - __uint_as_float(c.w & 0xffff0000u));
        afr[ks] = __builtin_bit_cast(bfx8, w);
    }
}
__device__ __forceinline__ void poolconv_rows(const bf16_t* __restrict__ proj, bf16_t* __restrict__ mix, const bf16_t* __restrict__ wpT, const float* __restrict__ pool_scale, const float* __restrict__ conv_w,
                                              int R0, LAS unsigned char* lds, int tid) {
    typedef __attribute__((ext_vector_type(8))) short bfx8; typedef __attribute__((ext_vector_type(16))) float fx16; typedef unsigned ux4 __attribute__((ext_vector_type(4)));
    constexpr int UP = POOL_UP;
    const int t0 = R0 % SEQ; const size_t rb = (size_t)(R0 - t0);
    const int lane = tid & 63, r32 = lane & 31, hi = lane >> 5, wid = __builtin_amdgcn_readfirstlane(tid >> 6);
    { ux4 v[9];
#pragma unroll
      for (int k = 0; k < 9; ++k) { const int i = tid + k * NTHR, r = i >> 5, c16 = i & 31, tt = t0 - 8 + r;
          v[k] = (ux4){0u, 0u, 0u, 0u}; if (tt >= 0 && tt < SEQ) v[k] = *(const ux4*)(proj + (rb + tt) * INW + O_P + c16 * 8); }
#pragma unroll
      for (int k = 0; k < 9; ++k) { const int i = tid + k * NTHR, r = i >> 5, c16 = i & 31; *(LAS ux4*)(lds + r * UP + c16 * 16) = v[k]; } }
    __syncthreads();
    const int blk = wid & 3;
#pragma unroll 1
    for (int task = 0; task < 2; ++task) {
        const int g = (wid >> 2) ? (task ? 2 : 1) : (task ? 3 : 0); const int hw = 1 << g;
        const int t = t0 + blk * 32 + r32; int lo = t - hw; if (lo < 0) lo = 0; int hi_ = t + hw; if (hi_ > SEQ) hi_ = SEQ;
        const float inv = 1.f / (float)(hi_ - lo);
        const LAS unsigned char* base = lds + (blk * 32 + r32 + 8) * UP + (g * 64 + hi * 8) * 2;
        bfx8 b0f[4], b1f[4];
#pragma unroll
        for (int ks = 0; ks < 4; ++ks) { b0f[ks] = *(const bfx8*)(wpT + (size_t)(g * 64 + r32) * 64 + ks * 16 + hi * 8); b1f[ks] = *(const bfx8*)(wpT + (size_t)(g * 64 + 32 + r32) * 64 + ks * 16 + hi * 8); }
        bfx8 afr[4];
        if (g == 0) pool_afr<1>(base, inv, afr); else if (g == 1) pool_afr<2>(base, inv, afr); else if (g == 2) pool_afr<4>(base, inv, afr); else pool_afr<8>(base, inv, afr);
        fx16 d0 = fx16{}, d1 = fx16{};
#pragma unroll
        for (int ks = 0; ks < 4; ++ks) {
            d0 = __builtin_amdgcn_mfma_f32_32x32x16_bf16(afr[ks], b0f[ks], d0, 0, 0, 0); d1 = __builtin_amdgcn_mfma_f32_32x32x16_bf16(afr[ks], b1f[ks], d1, 0, 0, 0);
        }
        const float ps0 = pool_scale[g * 64 + r32], ps1 = pool_scale[g * 64 + 32 + r32];
        bf16_t* op = mix + (size_t)(R0 + blk * 32) * D + 512 + g * 64 + r32;
#pragma unroll
        for (int r = 0; r < 16; ++r) { const int orow = (r & 3) + 8 * (r >> 2) + 4 * hi; op[(size_t)orow * D] = f2bf(d0[r] * ps0); op[(size_t)orow * D + 32] = f2bf(d1[r] * ps1); }
    }
    __syncthreads();
#pragma unroll 1
    for (int bt = 0; bt < 2; ++bt) {
        uint4 cb[4], cc[4], cx[4], cm[4], xm[4], cp[4], xp[4];
#pragma unroll
        for (int k = 0; k < 4; ++k) { const int i = tid + (bt * 4 + k) * NTHR, r = i >> 5, j0 = (i & 31) * 8, t = t0 + r; const bf16_t* pr = proj + (size_t)(R0 + r) * INW;
            const bf16_t* pm = t > 0 ? pr - INW : pr; const bf16_t* pp = t < SEQ - 1 ? pr + INW : pr;
            cb[k] = *(const uint4*)(pr + O_B + j0); cc[k] = *(const uint4*)(pr + O_C + j0); cx[k] = *(const uint4*)(pr + O_X + j0);
            cm[k] = *(const uint4*)(pm + O_C + j0); xm[k] = *(const uint4*)(pm + O_X + j0); cp[k] = *(const uint4*)(pp + O_C + j0); xp[k] = *(const uint4*)(pp + O_X + j0); }
#pragma unroll
        for (int k = 0; k < 4; ++k) { const int i = tid + (bt * 4 + k) * NTHR, r = i >> 5, j0 = (i & 31) * 8, t = t0 + r;
            const float mk_m = t > 0 ? 1.f : 0.f, mk_p = t < SEQ - 1 ? 1.f : 0.f;
            const bf16_t* pb = (const bf16_t*)&cb[k]; const bf16_t* pc = (const bf16_t*)&cc[k]; const bf16_t* px = (const bf16_t*)&cx[k];
            const bf16_t* pcm = (const bf16_t*)&cm[k]; const bf16_t* pxm = (const bf16_t*)&xm[k]; const bf16_t* pcp = (const bf16_t*)&cp[k]; const bf16_t* pxp = (const bf16_t*)&xp[k];
            float y[8];
#pragma unroll
            for (int e = 0; e < 8; ++e) { const int j = j0 + e;
                const float u0 = bf2f(pc[e]) * bf2f(px[e]), um = mk_m * (bf2f(pcm[e]) * bf2f(pxm[e])), up = mk_p * (bf2f(pcp[e]) * bf2f(pxp[e]));
                y[e] = bf2f(pb[e]) * (conv_w[j] * um + conv_w[256 + j] * u0 + conv_w[512 + j] * up); }
            uint4 o; o.x = pk2(y[0], y[1]); o.y = pk2(y[2], y[3]); o.z = pk2(y[4], y[5]); o.w = pk2(y[6], y[7]);
            *(uint4*)(mix + (size_t)(R0 + r) * D + 768 + j0) = o; } }
}

#define XB_TMO      128
#define XB_XCNT(j)  (256  + 64 * (j))
#define XB_XSUB(j)  (1280 + 64 * (j))
#define XB_XGEN(j)  (2304 + 64 * (j))
#define XB_TOP      3328
#define XB_TOPGEN   3392
#define XCD_BAR_WORDS 3456
#define XB_SPIN_CAP (1u << 18)

__device__ __forceinline__ unsigned xb_ld(unsigned* p)              { return __hip_atomic_load(p, __ATOMIC_RELAXED, __HIP_MEMORY_SCOPE_AGENT); }
__device__ __forceinline__ unsigned xb_add(unsigned* p, unsigned v) { return __hip_atomic_fetch_add(p, v, __ATOMIC_RELAXED, __HIP_MEMORY_SCOPE_AGENT); }
__device__ __forceinline__ unsigned xb_xcc_id() { return (unsigned)__builtin_amdgcn_s_getreg((3 << 11) | 20) & 0xFu; }
#define XB_SPIN(cond, bar) do { unsigned _sp = 0; while (cond) { __builtin_amdgcn_s_sleep(1); \
    if ((++_sp & 255u) == 0u) { if (xb_ld(&(bar)[XB_TMO])) break; if (_sp > XB_SPIN_CAP) { atomicAdd(&(bar)[XB_TMO], 1u); break; } } } } while (0)

struct XcdBarrier {
    unsigned* bar; unsigned x;
    volatile LAS unsigned* st;
};

__device__ __forceinline__ XcdBarrier xcd_barrier_post(unsigned* bar, volatile LAS unsigned* st) {
    XcdBarrier b; b.bar = bar; b.x = xb_xcc_id(); b.st = st;
    if (threadIdx.x == 0) (void)xb_add(&bar[XB_XCNT(b.x)], 1u);
    return b;
}
__device__ __forceinline__ void xcd_barrier_complete(unsigned* bar, unsigned x, unsigned& nloc, unsigned& nx) {
    const unsigned G = gridDim.x * gridDim.y * gridDim.z;
    unsigned sum, cnt, mine, sp = 0u;
    for (;;) {
        sum = 0u; cnt = 0u; mine = 0u;
#pragma unroll
        for (unsigned j = 0; j < 16; ++j) { const unsigned c = xb_ld(&bar[XB_XCNT(j)]); sum += c; cnt += (c > 0u) ? 1u : 0u; mine = (j == x) ? c : mine; }
        if (sum == G) break;
        __builtin_amdgcn_s_sleep(1);
        if ((++sp & 255u) == 0u) { if (xb_ld(&bar[XB_TMO])) break; if (sp > XB_SPIN_CAP) { atomicAdd(&bar[XB_TMO], 1u); break; } }
    }
    nloc = mine > 0u ? mine : 1u; nx = cnt > 0u ? cnt : 1u;
}

__device__ __forceinline__ void xcd_barrier(const XcdBarrier& b) {
    asm volatile("s_waitcnt vmcnt(0)" ::: "memory");
    __syncthreads();
    if (threadIdx.x == 0) {
        unsigned* bar = b.bar;
        __builtin_amdgcn_s_waitcnt(0);
        unsigned nloc = b.st[0], nx = b.st[1];
        if (nloc == 0u) { xcd_barrier_complete(bar, b.x, nloc, nx); b.st[0] = nloc; b.st[1] = nx; }
        const unsigned old = xb_add(&bar[XB_XSUB(b.x)], 1u);
        const unsigned gen = old / nloc;
        if (old + 1u == (gen + 1u) * nloc) {
            __builtin_amdgcn_fence(__ATOMIC_RELEASE, "agent");
            asm volatile("s_waitcnt vmcnt(0)" ::: "memory");
            const unsigned og = xb_add(&bar[XB_TOP], 1u);
            const unsigned tg = og / nx;
            if (og + 1u == (tg + 1u) * nx) xb_add(&bar[XB_TOPGEN], 1u);
            else XB_SPIN(xb_ld(&bar[XB_TOPGEN]) == tg, bar);
            __builtin_amdgcn_fence(__ATOMIC_ACQUIRE, "agent");
            xb_add(&bar[XB_XGEN(b.x)], 1u);
            asm volatile("s_waitcnt vmcnt(0)" ::: "memory");
        } else {
            XB_SPIN(xb_ld(&bar[XB_XGEN(b.x)]) == gen, bar);
            __builtin_amdgcn_fence(__ATOMIC_ACQUIRE, "agent");
            asm volatile("s_waitcnt vmcnt(0)" ::: "memory");
        }
    }
    __syncthreads();
}
#define XB_XSUB2(j) (12800 - 1024 + 64 * (j))
#define XB_XGEN2(j) (13824 - 1024 + 64 * (j))
#define XB_MISMAP   (14900 - 1024)
__device__ __forceinline__ void xcd_local_barrier(const XcdBarrier& b) {
    asm volatile("s_waitcnt vmcnt(0)" ::: "memory");
    __syncthreads();
    if (threadIdx.x == 0) {
        unsigned* bar = b.bar;
        __builtin_amdgcn_s_waitcnt(0);
        unsigned nloc = b.st[0], nx = b.st[1];
        if (nloc == 0u) { xcd_barrier_complete(bar, b.x, nloc, nx); b.st[0] = nloc; b.st[1] = nx; }
        const unsigned old = xb_add(&bar[XB_XSUB2(b.x)], 1u);
        const unsigned target = (old / nloc + 1u) * nloc;
        if (old + 1u != target) XB_SPIN(xb_ld(&bar[XB_XSUB2(b.x)]) < target, bar);
        __builtin_amdgcn_fence(__ATOMIC_ACQUIRE, "agent");
        asm volatile("s_waitcnt vmcnt(0)" ::: "memory");
    }
    __syncthreads();
}
constexpr int N_PHASES = 16;
#ifndef ATT_SKIP_T
#define ATT_SKIP_T 36
#endif
struct Args { const float* in[19]; float* out; unsigned char* ws; int ph_lo, ph_hi, li, pad; };
__device__ __forceinline__ const float* arg_in(int k) { const int o = launder_s(k * 8); return *(const float* const*)((const char*)__builtin_amdgcn_kernarg_segment_ptr() + o); }
__device__ __forceinline__ unsigned char* arg_ws() { const int o = launder_s(160); return *(unsigned char* const*)((const char*)__builtin_amdgcn_kernarg_segment_ptr() + o); }
__device__ __forceinline__ float* arg_out() { const int o = launder_s(152); return *(float* const*)((const char*)__builtin_amdgcn_kernarg_segment_ptr() + o); }
__global__ void __launch_bounds__(NTHR, 2) mk_fwd(Args a) {
    extern __shared__ __attribute__((aligned(16))) unsigned char lds[];
    cg::grid_group grid = cg::this_grid();
    const int tid = threadIdx.x, wave = __builtin_amdgcn_readfirstlane(tid >> 6);
#define lane (launder_v(tid) & 63)
    const int G = gridDim.x, bx = blockIdx.x; const int vcu = (G % 8 == 0) ? (bx % 8) * (G / 8) + bx / 8 : bx;
    const int gw = vcu * NWAVES + wave, ngw = G * NWAVES;
    __builtin_assume(gw >= 0 && gw < 4096 && ngw > 0);
    LAS unsigned char* ldsl = (LAS unsigned char*)lds;
#define ws (arg_ws())
#define x (arg_in(0))
#define out (arg_out())
#define mod ((float*)(ws + WS_MOD))
#define win_t ((bf16_t*)(ws + WS_WIN))
#define wout_t ((bf16_t*)(ws + WS_WOUT))
#define wgu_t ((bf16_t*)(ws + WS_WGU))
#define wdn_t ((bf16_t*)(ws + WS_WDN))
#define xb ((bf16_t*)(ws + WS_XB))
#define hb ((bf16_t*)(ws + WS_H))
#define mix ((bf16_t*)(ws + WS_MIX))
#define proj ((bf16_t*)(ws + WS_PROJ))
#define act ((bf16_t*)(ws + WS_ACT))
    const int lo = a.ph_lo, hi = a.ph_hi;
    const bool fuse = G == 256 && lo == 0 && hi == N_PHASES;
#define NORM_PART(k) ((float*)(ws + WS_PART) + (size_t)(k) * 131072)
#define NORM_CNT(k) ((unsigned*)(ws + WS_CTL) + 4608 + (k) * 2048)
#define NORM_LS ((LAS float*)(ldsl + MISC_OFF + 1024))
    for (int u = tid; u < (LDS_BYTES - MISC_OFF) / 4; u += NTHR) ((LAS unsigned*)(ldsl + MISC_OFF))[u] = 0u;
    __syncthreads();
    XcdBarrier bar = xcd_barrier_post((unsigned*)(ws + WS_CTL) + 1024 + a.li * XCD_BAR_WORDS, (volatile LAS unsigned*)(ldsl + MISC_OFF) + 8);
    if (tid == 0) (void)__hip_atomic_fetch_or(bar.bar + XB_MISMAP + (bx & 7), 1u << xb_xcc_id(), __ATOMIC_RELAXED, __HIP_MEMORY_SCOPE_AGENT);
#define IN(k) (lo <= (k) && (k) < hi)
#define INL(j) (lo <= (pb + (j)) && (pb + (j)) < hi)
#define SEAML(j) do { if (lo <= (pb + (j)) && (pb + (j)) + 1 < hi) { if (localok) xcd_local_barrier(bar); else xcd_barrier(bar); } } while (0)
#define SEAM(k) do { if (lo <= (k) && (k) + 1 < hi) grid.sync(); } while (0)

    if (IN(0)) {
        LAS float* scr = (LAS float*)(ldsl + wave * 16640);
        int cursor = 0;
        for (int l = 0; l < DEPTH; ++l) {
            p0_transpose_matrix(arg_in(5) + (size_t)l * D * INW, D, INW, win_t + (size_t)l * INW * D, false, scr, gw, ngw, lane, cursor);
            p0_transpose_matrix(arg_in(14) + (size_t)l * D * D, D, D, wout_t + (size_t)l * D * D, false, scr, gw, ngw, lane, cursor);
            p0_transpose_matrix(arg_in(16) + (size_t)l * D * NGU, D, NGU, wgu_t + (size_t)l * NGU * D, true, scr, gw, ngw, lane, cursor);
            p0_transpose_matrix(arg_in(17) + (size_t)l * DFF * D, DFF, D, wdn_t + (size_t)l * D * DFF, false, scr, gw, ngw, lane, cursor);
        }
        { bf16_t* wpT = (bf16_t*)(ws + WS_WPT);
          for (int i = gw * 64 + lane; i < DEPTH * 4 * 4096; i += ngw * 64) { const int lg = i >> 12, d = (i >> 6) & 63, c = i & 63; wpT[i] = f2bf(arg_in(11)[(size_t)lg * 4096 + c * 64 + d]); } }
        __syncthreads();
        for (int u = bx; u < 192; u += G) p0_mod_unit(arg_in(1), arg_in(2), arg_in(3), mod, u, (LAS float*)ldsl, tid);
    }
    SEAM(0);
    bool localok = fuse;
    for (int g8 = 0; g8 < 8; ++g8) { const unsigned mk = (unsigned)__builtin_amdgcn_readfirstlane((int)xb_ld((unsigned*)(ws + WS_CTL) + 1024 + XB_MISMAP + g8)); localok = localok && mk != 0u && (mk & (mk - 1u)) == 0u; }

    for (int l = 0; l < DEPTH; ++l) {
        const int pb = launder_s(1 + 7 * l);
        const float* modl = mod + (size_t)l * 8 * 6144;
        if (INL(0) && !(fuse && l > 0)) {
            const int m_lo = fuse ? (bx & 7) * SEQ + ((bx >> 3) * NWAVES + wave) * 16 : gw * 4, m_hi = fuse ? m_lo + 16 : M, m_st = fuse ? 4 : ngw * 4;
            for (int m = m_lo; m < m_hi; m += m_st) { const float* mb = modl + (size_t)(m / SEQ) * 6144;
                if (l == 0) norm_rows<true, true, 4>(x + (size_t)m * D, arg_in(4) + l * D, mb + 0, mb + 1024, hb + (size_t)m * D, nullptr, lane);
                else norm_rows<false, true, 4>(xb + (size_t)m * D, arg_in(4) + l * D, mb + 0, mb + 1024, hb + (size_t)m * D, nullptr, lane); }
        }
        if (!(fuse && l > 0)) SEAML(0);
        if (INL(1)) {
            pg8::Gemm g{hb, win_t + (size_t)l * INW * D, M, INW, D}; pg8::StaticOrder S; S.init(M, INW, G, bx);
            pg8::EpiProj E{proj, INW, C2, (unsigned*)(ws + WS_KN2) + l * 8192, BPAD};
            pg8::gemm_phase<pg8::EpiProj, pg8::StaticOrder, true, true>(ldsl, g, S, E);
        }
        SEAML(1);
        if (INL(2)) {
            const float lambda_init = l == 0 ? 0.2f : 0.35550906759096926f;
            float d1 = 0.f, d2 = 0.f;
            for (int i = 0; i < 32; ++i) { d1 += arg_in(6)[l * 32 + i] * arg_in(7)[l * 32 + i]; d2 += arg_in(8)[l * 32 + i] * arg_in(9)[l * 32 + i]; }
            const float lam = __expf(d1) - __expf(d2) + lambda_init;
            const unsigned* kn2 = (const unsigned*)(ws + WS_KN2) + l * 8192;
            {
                const bool useq = G == 256; const int xg = bx & 7;
                unsigned* qcnt = (unsigned*)(ws + WS_CTL) + 15000 + (l * 8 + xg) * 64;
                volatile LAS unsigned* qw = (volatile LAS unsigned*)(ldsl + MISC_OFF) + 16;
                if (useq) { if (tid == 0) qw[0] = __hip_atomic_fetch_add(qcnt, 1u, __ATOMIC_RELAXED, __HIP_MEMORY_SCOPE_AGENT); __syncthreads(); }
                int sidx = bx;
                for (int it = 0;; ++it) {
                    int idx, bsel; unsigned nxt = 0u;
                    if (useq) { idx = (int)qw[it & 1]; if (idx >= 160) break; bsel = xg; if (tid == 0) nxt = __hip_atomic_fetch_add(qcnt, 1u, __ATOMIC_RELAXED, __HIP_MEMORY_SCOPE_AGENT); }
                    else { if (sidx >= BATCH * 160) break; bsel = sidx / 160; idx = sidx % 160; sidx += G; }
                    const int cls = idx >> 4, e = idx & 15;
                    if (cls >= 8) {
                        const int r = bsel * 32 + (idx - 128);
                        poolconv_rows(proj + (size_t)bsel * BPAD, mix, (const bf16_t*)(ws + WS_WPT) + (size_t)l * 4 * 4096, arg_in(12) + l * 256, arg_in(13) + l * 768, r * 128, ldsl, launder_v(tid));
                    } else {
                        const int hsel = 7 - cls;
                        const int qb = (e & 1) ? 8 + (e >> 1) : 7 - (e >> 1);
                        att::attn_unit<20, ATT_SKIP_T>(bsel, hsel, qb, proj + (size_t)bsel * BPAD, mix, arg_in(10) + l * 512 + hsel * 64, lam, 1.f - lambda_init, kn2, (char*)lds);
                    }
                    if (useq && tid == 0) qw[(it + 1) & 1] = nxt;
                    __syncthreads();
                }
            }
        }
        SEAML(2);
        if (INL(3)) {
            pg8::Gemm g{mix, wout_t + (size_t)l * D * D, M, D, D}; pg8::StaticOrder S; S.init(M, D, G, bx);
            if (fuse) {
                if (l == 0) { pg8::EpiResidNorm<true, false> E{x, xb, D, modl + 2048, SEQ, arg_in(15) + l * D, modl + 3072, modl + 4096, hb, nullptr, NORM_PART(2 * l), NORM_CNT(2 * l), NORM_LS}; pg8::gemm_phase<pg8::EpiResidNorm<true, false>, pg8::StaticOrder, true, true>(ldsl, g, S, E); }
                else { pg8::EpiResidNorm<false, false> E{xb, xb, D, modl + 2048, SEQ, arg_in(15) + l * D, modl + 3072, modl + 4096, hb, nullptr, NORM_PART(2 * l), NORM_CNT(2 * l), NORM_LS}; pg8::gemm_phase<pg8::EpiResidNorm<false, false>, pg8::StaticOrder, true, true>(ldsl, g, S, E); }
            } else {
            if (l == 0) { pg8::EpiResid<true> E{x, xb, D, modl + 2048, SEQ}; pg8::gemm_phase<pg8::EpiResid<true>, pg8::StaticOrder, true, true>(ldsl, g, S, E); }
            else { pg8::EpiResid<false> E{xb, xb, D, modl + 2048, SEQ}; pg8::gemm_phase<pg8::EpiResid<false>, pg8::StaticOrder, true, true>(ldsl, g, S, E); }
            }
        }
        if (!fuse) SEAML(3);
        if (INL(4) && !fuse) {
            for (int m = gw * 4; m < M; m += ngw * 4) { const float* mb = modl + (size_t)(m / SEQ) * 6144;
                norm_rows<false, true, 4>(xb + (size_t)m * D, arg_in(15) + l * D, mb + 3072, mb + 4096, hb + (size_t)m * D, nullptr, lane); }
        }
        SEAML(4);
        if (INL(5)) {
            pg8::Gemm g{hb, wgu_t + (size_t)l * NGU * D, M, NGU, D}; pg8::StaticOrder S; S.init(M, NGU, G, bx);
            pg8::EpiSwiglu E{act, DFF};
            pg8::gemm_phase<pg8::EpiSwiglu, pg8::StaticOrder, true, true>(ldsl, g, S, E);
        }
        SEAML(5);
        if (INL(6)) {
            pg8::Gemm g{act, wdn_t + (size_t)l * D * DFF, M, D, DFF}; pg8::StaticOrder S; S.init(M, D, G, bx);
            if (fuse) {
                if (l + 1 < DEPTH) { const float* modn = mod + (size_t)(l + 1) * 8 * 6144;
                    pg8::EpiResidNorm<false, false> E{xb, xb, D, modl + 5120, SEQ, arg_in(4) + (l + 1) * D, modn + 0, modn + 1024, hb, nullptr, NORM_PART(2 * l + 1), NORM_CNT(2 * l + 1), NORM_LS}; pg8::gemm_phase<pg8::EpiResidNorm<false, false>, pg8::StaticOrder, true, true>(ldsl, g, S, E); }
                else { pg8::EpiResidNorm<false, true> E{xb, xb, D, modl + 5120, SEQ, arg_in(18), nullptr, nullptr, nullptr, out, NORM_PART(2 * l + 1), NORM_CNT(2 * l + 1), NORM_LS}; pg8::gemm_phase<pg8::EpiResidNorm<false, true>, pg8::StaticOrder, true, true>(ldsl, g, S, E); }
            } else {
            pg8::EpiResid<false> E{xb, xb, D, modl + 5120, SEQ};
            pg8::gemm_phase<pg8::EpiResid<false>, pg8::StaticOrder, true, true>(ldsl, g, S, E);
            }
        }
        if (!(fuse && l + 1 == DEPTH)) SEAML(6);
    }
    if (IN(15) && !fuse) {
        for (int m = gw * 4; m < M; m += ngw * 4) norm_rows<false, false, 4>(xb + (size_t)m * D, arg_in(18), nullptr, nullptr, nullptr, out + (size_t)m * D, lane);
    }
#undef lane
#undef ws
#undef x
#undef out
#undef mod
#undef win_t
#undef wout_t
#undef wgu_t
#undef wdn_t
#undef xb
#undef hb
#undef mix
#undef proj
#undef act
#undef IN
#undef INL
#undef SEAM
#undef SEAML
#undef NORM_PART
#undef NORM_CNT
#undef NORM_LS
}

extern "C" void kernel_launch(void* const* d_in, const int* in_sizes, int n_in, void* d_out, int out_size, void* d_ws, size_t ws_size, hipStream_t stream) {
    static int grid = 0;
    if (grid == 0) {
        if (n_in != 19 || in_sizes[0] != M * D || out_size != M * D || ws_size < WS_END) { fprintf(stderr, "kernel_launch: unexpected shapes / workspace (n_in %d, ws %zu); nothing launched\n", n_in, ws_size); grid = -1; return; }
        int dev = 0, cus = 0, per_cu = 0;
        if (hipGetDevice(&dev) != hipSuccess || hipDeviceGetAttribute(&cus, hipDeviceAttributeMultiprocessorCount, dev) != hipSuccess) { grid = -1; return; }
        if (hipFuncSetAttribute((const void*)mk_fwd, hipFuncAttributeMaxDynamicSharedMemorySize, LDS_BYTES) != hipSuccess) { fprintf(stderr, "kernel_launch: hipFuncSetAttribute failed\n"); grid = -1; return; }
        if (hipOccupancyMaxActiveBlocksPerMultiprocessor(&per_cu, (const void*)mk_fwd, NTHR, LDS_BYTES) != hipSuccess || per_cu < 1) { fprintf(stderr, "kernel_launch: occupancy query says %d blocks per CU\n", per_cu); (void)hipGetLastError(); grid = -1; return; }
        grid = cus;
    }
    if (grid < 0) return;
    (void)hipMemsetAsync((char*)d_ws + WS_CTL, 0, CTL_ZERO_BYTES, stream);
    Args a{};
    for (int i = 0; i < 19; ++i) a.in[i] = (const float*)d_in[i];
    a.out = (float*)d_out; a.ws = (unsigned char*)d_ws;
    a.ph_lo = 0; a.ph_hi = N_PHASES; a.li = 0;
    void* args[] = {&a};
    const hipError_t le = hipLaunchCooperativeKernel((const void*)mk_fwd, dim3(grid), dim3(NTHR), args, LDS_BYTES, stream);
    if (le != hipSuccess) fprintf(stderr, "kernel_launch: cooperative launch failed: %s (grid %d)\n", hipGetErrorString(le), grid);
}
```
